# Optimizing an MI355X kernel written in HIP

```python
import jax, jax.numpy as jnp
from jax import lax
import numpy as np

D_MODEL = 1024
BATCH = 8
SEQ = 4096
DEPTH = 2

D_CONV = D_MODEL
CONV_WIDTH = 3
RET_HEADS = 4
RET_QK_DIM = 128
RET_V_DIM = 256
RET_QK = RET_HEADS * RET_QK_DIM
RET_V = RET_HEADS * RET_V_DIM
CHUNK = 128
ROPE_BASE = 10000.0
D_FF = 4 * D_MODEL
EPS = 1e-6
MAX_START = 1024

IN_SIZES = (D_CONV, D_CONV, D_CONV, RET_QK, RET_QK, RET_V, RET_V, D_MODEL, D_MODEL)
D_IN = 3 * D_CONV + 2 * RET_QK + 2 * RET_V + 2 * D_MODEL

kernel_name = "hybrid_conv_retention_gated_block"


def rmsnorm(x, g):
    xf = x.astype(jnp.float32)
    xf = xf * lax.rsqrt(jnp.mean(xf * xf, axis=-1, keepdims=True) + EPS)
    return (xf * g.astype(jnp.float32)).astype(x.dtype)


def rotary(t, positions):
    half = t.shape[-1] // 2
    inv_freq = ROPE_BASE ** (-jnp.arange(half, dtype=jnp.float32) / half)
    ang = positions.astype(jnp.float32)[..., None] * inv_freq
    cos = jnp.cos(ang)[:, :, None, :].astype(t.dtype)
    sin = jnp.sin(ang)[:, :, None, :].astype(t.dtype)
    t1, t2 = t[..., :half], t[..., half:]
    return jnp.concatenate([t1 * cos - t2 * sin, t1 * sin + t2 * cos], axis=-1)


def short_conv_mixer(b, c, u, conv_w, w_out):
    z = c * u
    z = lax.conv_general_dilated(
        z, conv_w[:, None, :].astype(z.dtype), window_strides=(1,),
        padding=[(CONV_WIDTH - 1, 0)], dimension_numbers=("NWC", "WIO", "NWC"),
        feature_group_count=D_CONV)
    return (b * z) @ w_out


def retention_core(q, k, v, positions):
    bsz, seq = q.shape[0], q.shape[1]
    n_chunks = seq // CHUNK
    q = rotary(q, positions) * (RET_QK_DIM ** -0.5)
    k = rotary(k, positions)

    def to_chunks(t):
        return t.astype(jnp.float32).reshape(bsz, n_chunks, CHUNK, RET_HEADS, t.shape[-1]).swapaxes(0, 1)

    qc, kc, vc = to_chunks(q), to_chunks(k), to_chunks(v)
    log_gamma = jnp.log1p(-jnp.exp2(-5.0 - jnp.arange(RET_HEADS, dtype=jnp.float32)))
    pos = jnp.arange(CHUNK, dtype=jnp.float32)
    rel = pos[:, None] - pos[None, :]
    decay_intra = jnp.where(rel >= 0, jnp.exp(log_gamma[:, None, None] * jnp.maximum(rel, 0.0)), 0.0)
    decay_q = jnp.exp((pos[:, None] + 1.0) * log_gamma)
    decay_k = jnp.exp((CHUNK - 1.0 - pos[:, None]) * log_gamma)
    decay_chunk = jnp.exp(CHUNK * log_gamma)

    scores = jnp.einsum("nbqhd,nbkhd->nbhqk", qc, kc) * decay_intra
    o_intra = jnp.einsum("nbhqk,nbkhv->nbqhv", scores, vc)

    def step(state, inp):
        q_i, k_i, v_i = inp
        o_inter = jnp.einsum("bqhd,bhdv->bqhv", q_i, state) * decay_q[None, :, :, None]
        state = state * decay_chunk[None, :, None, None] + jnp.einsum("bkhd,kh,bkhv->bhdv", k_i, decay_k, v_i)
        return state, o_inter

    state0 = jnp.zeros((bsz, RET_HEADS, RET_QK_DIM, RET_V_DIM), jnp.float32)
    _, o_inter = lax.scan(step, state0, (qc, kc, vc))
    return (o_intra + o_inter).swapaxes(0, 1).reshape(bsz, seq, RET_HEADS, RET_V_DIM)


def retention_mixer(q, k, v, g, positions, ret_norm, w_out):
    bsz, seq = q.shape[0], q.shape[1]
    o = retention_core(q.reshape(bsz, seq, RET_HEADS, RET_QK_DIM),
                       k.reshape(bsz, seq, RET_HEADS, RET_QK_DIM),
                       v.reshape(bsz, seq, RET_HEADS, RET_V_DIM), positions)
    mu = jnp.mean(o, axis=-1, keepdims=True)
    var = jnp.mean(jnp.square(o - mu), axis=-1, keepdims=True)
    o = ((o - mu) * lax.rsqrt(var + EPS)).reshape(bsz, seq, RET_V) * ret_norm.astype(jnp.float32)
    o = o.astype(g.dtype)
    return (jax.nn.silu(g) * o) @ w_out


def hybrid_layer(x, positions, norm_mix, w_in, conv_w, w_conv_out, ret_norm, w_ret_out, w_o,
                 norm_mlp, w_up, w_down):
    h = rmsnorm(x, norm_mix)
    proj = h @ w_in
    split_points = np.cumsum(IN_SIZES)[:-1].tolist()
    cb, cc, cu, q, k, v, g, ga, gb = jnp.split(proj, split_points, axis=-1)
    y_conv = short_conv_mixer(cb, cc, cu, conv_w, w_conv_out)
    y_ret = retention_mixer(q, k, v, g, positions, ret_norm, w_ret_out)
    merged = jax.nn.sigmoid(ga) * y_conv + jax.nn.sigmoid(gb) * y_ret
    x = x + merged @ w_o
    h2 = rmsnorm(x, norm_mlp)
    return x + jnp.square(jax.nn.relu(h2 @ w_up)) @ w_down


def setup_inputs(seed: int = 0) -> dict:
    key = jax.random.key(seed)
    ks = jax.random.split(key, 14)
    f32 = jnp.float32

    def dense(k, fan_in, fan_out):
        return jax.random.normal(k, (DEPTH, fan_in, fan_out), f32) * (fan_in ** -0.5)

    def gain(k, shape):
        return 1.0 + 0.02 * jax.random.normal(k, shape, f32)

    x = jax.random.normal(ks[0], (BATCH, SEQ, D_MODEL), f32)
    start = jax.random.randint(ks[1], (BATCH, 1), 0, MAX_START, dtype=jnp.int32)
    positions = (start + jnp.arange(SEQ, dtype=jnp.int32)[None, :]).astype(jnp.int32)
    return {
        "x": x,
        "positions": positions,
        "norm_mix": gain(ks[2], (DEPTH, D_MODEL)),
        "w_in": dense(ks[3], D_MODEL, D_IN),
        "conv_w": jax.random.normal(ks[4], (DEPTH, CONV_WIDTH, D_CONV), f32) * (CONV_WIDTH ** -0.5),
        "w_conv_out": dense(ks[5], D_CONV, D_MODEL),
        "ret_norm": gain(ks[6], (DEPTH, RET_V)),
        "w_ret_out": dense(ks[7], RET_V, D_MODEL),
        "w_o": dense(ks[8], D_MODEL, D_MODEL),
        "norm_mlp": gain(ks[9], (DEPTH, D_MODEL)),
        "w_up": dense(ks[10], D_MODEL, D_FF),
        "w_down": dense(ks[11], D_FF, D_MODEL),
        "norm_final": gain(ks[12], (D_MODEL,)),
    }


def reference(x, positions, norm_mix, w_in, conv_w, w_conv_out, ret_norm, w_ret_out, w_o,
              norm_mlp, w_up, w_down, norm_final):
    for i in range(DEPTH):
        x = hybrid_layer(x, positions, norm_mix[i], w_in[i], conv_w[i], w_conv_out[i], ret_norm[i],
                         w_ret_out[i], w_o[i], norm_mlp[i], w_up[i], w_down[i])
    return rmsnorm(x, norm_final)
```

```cpp
#include <hip/hip_runtime.h>
#include <hip/hip_cooperative_groups.h>
#include <cstdio>
#include <cstdint>
namespace cg = cooperative_groups;
namespace pg8 {
#define PG8_LAS __attribute__((address_space(3)))
typedef unsigned short bf16_t;
typedef short bf16x8 __attribute__((ext_vector_type(8)));
typedef float f32x4 __attribute__((ext_vector_type(4)));
typedef unsigned u32x4 __attribute__((ext_vector_type(4)));
constexpr int BM = 256, BK = 64, HALF = 128, HTB = HALF * BK * 2  , STAGE_BYTES = 8 * HTB, NXCD = 8, WGM = 8;

__host__ __device__ __forceinline__ int lds_byte(int r, int c) { const int st = (r >> 4) * 2 + (c >> 5), rr = r & 15, cc = c & 31, ob = rr * 64 + cc * 2; return st * 1024 + (ob ^ (((ob >> 9) & 1) << 5)); }
__host__ __device__ __forceinline__ void stage_rc(int b, int& R, int& C) { const int st = b / 1024, sb = b % 1024, swz = sb ^ (((sb >> 9) & 1) << 5); R = (st >> 1) * 16 + swz / 64; C = (st & 1) * 32 + (swz % 64) / 2; }
__host__ __device__ __forceinline__ int perm32(int rho) { const int n = rho >> 4, i = rho & 15; return 8 * (i >> 2) + 4 * n + (i & 3); }

struct Unit { int pm, pn; };
struct Gemm { const bf16_t* A; const bf16_t* Bt; int M, N, K; };

struct StaticOrder {
    int nM, nN, nwg, G, c;
    __host__ __device__ void init(int M, int N, int G_, int c_) { nM = M / BM; nN = N / BM; nwg = nM * nN; G = G_; c = c_; }
    __host__ __device__ bool next(int i, Unit& u) const {
        const long L = (long)i * G + c; if (L >= nwg) return false;
        int wgid = (int)L; { const int q = nwg / NXCD, r = nwg % NXCD, xcd = wgid % NXCD, off = wgid / NXCD; wgid = (xcd < r ? xcd * (q + 1) : r * (q + 1) + (xcd - r) * q) + off; }
        const int nig = WGM * nN, gid = wgid / nig, fm = gid * WGM, gsz = (nM - fm) < WGM ? (nM - fm) : WGM;
        u.pm = fm + ((wgid % nig) % gsz); u.pn = (wgid % nig) / gsz; return true;
    }
    __device__ __forceinline__ void a_ready(const Unit&) const {}
    __device__ __forceinline__ void done(const Unit&) const {}
};

__device__ __forceinline__ unsigned cvt_pk_bf16(float lo, float hi) { unsigned r; asm volatile("v_cvt_pk_bf16_f32 %0, %1, %2" : "=v"(r) : "v"(lo), "v"(hi)); return r; }
typedef float f32x2 __attribute__((ext_vector_type(2)));

constexpr float NORM_EPS = 1e-6f;
template <int ACT> struct EpiScaleBf16 {
    static constexpr bool PERM = true, AFTER_DRAIN = false, MIDHOOK = false;
    bf16_t* O; int ldc; const float* ss;
    __device__ __forceinline__ void operator()(const f32x4 (&acc)[2][2][4][2], const Unit& u, int wr, int wc, int fr, int fq) const {
        int row0 = u.pm * BM + wr * 64 + fr; asm volatile("" : "+v"(row0)); const int col0 = u.pn * BM + wc * 32 + 8 * fq;
#pragma unroll
        for (int ai = 0; ai < 2; ++ai)
#pragma unroll
            for (int m = 0; m < 4; ++m) { const int row = row0 + ai * HALF + m * 16; const float r = rsqrtf(ss[row] * (1.0f / 1024.0f) + NORM_EPS);
                bf16_t* rowp = O + (size_t)row * ldc + col0;
#pragma unroll
                for (int bj = 0; bj < 2; ++bj) { f32x4 v0 = acc[ai][bj][m][0] * r, v1 = acc[ai][bj][m][1] * r;
                    if (ACT == 1) {
#pragma unroll
                        for (int j = 0; j < 4; ++j) { const float a = fmaxf(v0[j], 0.f), b = fmaxf(v1[j], 0.f); v0[j] = a * a; v1[j] = b * b; } }
                    u32x4 w; w.x = cvt_pk_bf16(v0[0], v0[1]); w.y = cvt_pk_bf16(v0[2], v0[3]); w.z = cvt_pk_bf16(v1[0], v1[1]); w.w = cvt_pk_bf16(v1[2], v1[3]);
                    *(u32x4*)(rowp + bj * HALF) = w; } }
    }
};
__device__ __forceinline__ float bf_lo(unsigned w) { return __uint_as_float(w << 16); }
__device__ __forceinline__ float bf_hi(unsigned w) { return __uint_as_float(w & 0xffff0000u); }
__device__ __forceinline__ float clamp30(float x) { return fminf(fmaxf(x, -30.f), 30.f); }
struct EpiMerge {
    static constexpr bool PERM = true, AFTER_DRAIN = false, MIDHOOK = true;
    const bf16_t* proj; bf16_t* O;
    __device__ __forceinline__ void mid(f32x4 (&acc)[2][2][4][2], const Unit& u, int wr, int wc, int fr, int fq) const {
        int row0 = u.pm * BM + wr * 64 + fr; asm volatile("" : "+v"(row0)); const int col0 = u.pn * BM + wc * 32 + 8 * fq;
#pragma unroll
        for (int ai = 0; ai < 2; ++ai)
#pragma unroll
            for (int m = 0; m < 4; ++m) { const bf16_t* rowp = proj + (size_t)(row0 + ai * HALF + m * 16) * 8192 + col0;
#pragma unroll
                for (int bj = 0; bj < 2; ++bj) { const u32x4 a = *(const u32x4*)(rowp + 6144 + bj * HALF), b = *(const u32x4*)(rowp + 7168 + bj * HALF);
#pragma unroll
                    for (int j = 0; j < 4; ++j) { const float ea0 = __expf(-clamp30(bf_lo(a[j]))), ea1 = __expf(-clamp30(bf_hi(a[j]))), eb0 = __expf(-clamp30(bf_lo(b[j]))), eb1 = __expf(-clamp30(bf_hi(b[j])));
                        const float r0 = (1.f + eb0) / (1.f + ea0), r1 = (1.f + eb1) / (1.f + ea1);
                        acc[ai][bj][m][j >> 1][(j & 1) * 2] *= r0; acc[ai][bj][m][j >> 1][(j & 1) * 2 + 1] *= r1; } }
                asm volatile("" ::: "memory"); }
    }
    __device__ __forceinline__ void operator()(const f32x4 (&acc)[2][2][4][2], const Unit& u, int wr, int wc, int fr, int fq) const {
        int row0 = u.pm * BM + wr * 64 + fr; asm volatile("" : "+v"(row0)); const int col0 = u.pn * BM + wc * 32 + 8 * fq;
#pragma unroll
        for (int ai = 0; ai < 2; ++ai)
#pragma unroll
            for (int m = 0; m < 4; ++m) { const size_t row = (size_t)(row0 + ai * HALF + m * 16); const bf16_t* rowp = proj + row * 8192 + 7168 + col0;
#pragma unroll
                for (int bj = 0; bj < 2; ++bj) { const u32x4 b = *(const u32x4*)(rowp + bj * HALF); float v[8];
#pragma unroll
                    for (int j = 0; j < 4; ++j) { const float s0 = 1.f / (1.f + __expf(-clamp30(bf_lo(b[j])))), s1 = 1.f / (1.f + __expf(-clamp30(bf_hi(b[j]))));
                        v[2 * j] = acc[ai][bj][m][j >> 1][(j & 1) * 2] * s0; v[2 * j + 1] = acc[ai][bj][m][j >> 1][(j & 1) * 2 + 1] * s1; }
                    u32x4 w; w.x = cvt_pk_bf16(v[0], v[1]); w.y = cvt_pk_bf16(v[2], v[3]); w.z = cvt_pk_bf16(v[4], v[5]); w.w = cvt_pk_bf16(v[6], v[7]);
                    *(u32x4*)(O + row * 1024 + col0 + bj * HALF) = w; }
                asm volatile("" ::: "memory"); }
    }
};
struct EpiResidual {
    static constexpr bool PERM = false, AFTER_DRAIN = false, MIDHOOK = false;
    const float* base; float* out; bf16_t* xb; float* ss;
    __device__ __forceinline__ void operator()(const f32x4 (&acc)[2][2][4][2], const Unit& u, int wr, int wc, int fr, int fq) const {
        typedef unsigned u32x2v __attribute__((ext_vector_type(2)));
        int row0 = u.pm * BM + wr * 64 + fr; asm volatile("" : "+v"(row0)); const int col0 = u.pn * BM + wc * 32 + 4 * fq;
#pragma unroll
        for (int ai = 0; ai < 2; ++ai)
#pragma unroll
            for (int m = 0; m < 4; ++m) { const int row = row0 + ai * HALF + m * 16; const size_t off = (size_t)row * 1024 + col0; float s = 0.f;
#pragma unroll
                for (int bj = 0; bj < 2; ++bj)
#pragma unroll
                    for (int n = 0; n < 2; ++n) { const f32x4 bs = *(const f32x4*)(base + off + bj * HALF + n * 16); const f32x4 v = bs + acc[ai][bj][m][n];
                        *(f32x4*)(out + off + bj * HALF + n * 16) = v; u32x2v w; w.x = cvt_pk_bf16(v[0], v[1]); w.y = cvt_pk_bf16(v[2], v[3]);
                        *(u32x2v*)(xb + off + bj * HALF + n * 16) = w; s += (v[0] * v[0] + v[1] * v[1]) + (v[2] * v[2] + v[3] * v[3]); }
                s += __shfl_xor(s, 16); s += __shfl_xor(s, 32);
                if (fq == 0) __hip_atomic_fetch_add(ss + row, s, __ATOMIC_RELAXED, __HIP_MEMORY_SCOPE_AGENT);
                asm volatile("" ::: "memory"); }
    }
};

template <class Epi, class Sched, bool ALIGN_EPI = false, bool SP2 = false>
__device__ __forceinline__ void gemm_phase(PG8_LAS unsigned char* lds, const Gemm g, const Sched& S, const Epi& E) {
    int tid_ = threadIdx.x; asm volatile("" : "+v"(tid_));
    const int tid = tid_, wid = __builtin_amdgcn_readfirstlane(tid >> 6), lane = tid & 63, wr = wid >> 2, wc = wid & 3, fr = lane & 15, fq = lane >> 4;
    const int K = g.K, nt = K / BK;
    unsigned voffA[2], voffB[2];
#pragma unroll
    for (int i = 0; i < 2; ++i) { int R, C; stage_rc(tid * 16 + i * 8192, R, C); const int Rb = Epi::PERM ? ((R & ~31) + perm32(R & 31)) : R;
        voffA[i] = (unsigned)(R * K + C) * 2u; voffB[i] = (unsigned)(Rb * K + C) * 2u; }
    const size_t kstep = (size_t)(BK * 2);
    const size_t hstep = (size_t)HALF * K * 2;
    const size_t tstep = 2 * hstep;
    const unsigned ldsw = (unsigned)wid * 1024u;
    const int aoff = lds_byte(wr * 64 + fr, fq * 8), boff = lds_byte(wc * 32 + fr, fq * 8);
#define PG8_SA(b, h) (((b) * 2 + (h)) * HTB)
#define PG8_SB(b, h) ((4 + (b) * 2 + (h)) * HTB)
#define PG8_STAGE(bufoff, gbase, voff) do { _Pragma("unroll") for (int _i = 0; _i < 2; ++_i) \
        __builtin_amdgcn_global_load_lds((const unsigned*)((const char*)(gbase) + (voff)[_i]), (PG8_LAS unsigned*)(lds + (bufoff) + ldsw + _i * 8192), 16, 0, 0); } while (0)
#define PG8_LDA(dst, b, h) do { _Pragma("unroll") for (int m = 0; m < 4; ++m) _Pragma("unroll") for (int k = 0; k < 2; ++k) dst[m][k] = *(const PG8_LAS bf16x8*)(lds + PG8_SA(b, h) + aoff + m * 2048 + k * 1024); } while (0)
#define PG8_LDB(dst, b, h) do { _Pragma("unroll") for (int n = 0; n < 2; ++n) _Pragma("unroll") for (int k = 0; k < 2; ++k) dst[n][k] = *(const PG8_LAS bf16x8*)(lds + PG8_SB(b, h) + boff + n * 2048 + k * 1024); } while (0)
#define PG8_MMA(ai, bj, At, Bt) do { __builtin_amdgcn_s_setprio(1); _Pragma("unroll") for (int m = 0; m < 4; ++m) _Pragma("unroll") for (int n = 0; n < 2; ++n) _Pragma("unroll") for (int k = 0; k < 2; ++k) \
        acc[ai][bj][m][n] = __builtin_amdgcn_mfma_f32_16x16x32_bf16(Bt[n][k], At[m][k], acc[ai][bj][m][n], 0, 0, 0); __builtin_amdgcn_s_setprio(0); } while (0)
#define PG8_WAIT_V(n) asm volatile("s_waitcnt vmcnt(" #n ")" ::: "memory")
#define PG8_WAIT_L(n) asm volatile("s_waitcnt lgkmcnt(" #n ")" ::: "memory")
#define PG8_BAR __builtin_amdgcn_s_barrier()
#define PG8_SCHED __builtin_amdgcn_sched_barrier(0)
    Unit cur, nxt; int ui = 0;
    if (!S.next(0, cur)) return;
    f32x4 acc[2][2][4][2];
#pragma unroll
    for (int a = 0; a < 2; ++a)
#pragma unroll
        for (int b = 0; b < 2; ++b)
#pragma unroll
            for (int m = 0; m < 4; ++m)
#pragma unroll
                for (int n = 0; n < 2; ++n) acc[a][b][m][n] = (f32x4){0.f, 0.f, 0.f, 0.f};
    bf16x8 At[4][2], B0[2][2], B1[2][2];
    const char* cA = (const char*)g.A + (size_t)cur.pm * tstep; const char* cB = (const char*)g.Bt + (size_t)cur.pn * tstep;
    S.a_ready(cur);
    if constexpr (SP2) {
        PG8_STAGE(PG8_SB(0, 0), cB, voffB); PG8_STAGE(PG8_SB(0, 1), cB + hstep, voffB); PG8_STAGE(PG8_SA(0, 0), cA, voffA); PG8_STAGE(PG8_SA(0, 1), cA + hstep, voffA);
        if (wr == 1) PG8_BAR;
        PG8_WAIT_V(2); PG8_BAR;
        PG8_STAGE(PG8_SB(1, 0), cB + kstep, voffB); PG8_STAGE(PG8_SA(1, 0), cA + kstep, voffA); PG8_STAGE(PG8_SB(1, 1), cB + hstep + kstep, voffB);
        PG8_WAIT_V(6); PG8_BAR;
    } else {
        PG8_STAGE(PG8_SB(0, 0), cB, voffB); PG8_STAGE(PG8_SA(0, 0), cA, voffA); PG8_STAGE(PG8_SB(0, 1), cB + hstep, voffB); PG8_STAGE(PG8_SA(0, 1), cA + hstep, voffA);
        if (wr == 1) PG8_BAR;
        PG8_WAIT_V(4); PG8_BAR;
        PG8_STAGE(PG8_SB(1, 0), cB + kstep, voffB); PG8_STAGE(PG8_SA(1, 0), cA + kstep, voffA); PG8_STAGE(PG8_SB(1, 1), cB + hstep + kstep, voffB);
        PG8_WAIT_V(6); PG8_BAR;
    }
    for (;;) {
        const bool has_next = S.next(ui + 1, nxt);
        const char* nA = has_next ? (const char*)g.A + (size_t)nxt.pm * tstep : cA; const char* nB = has_next ? (const char*)g.Bt + (size_t)nxt.pn * tstep : cB;
        for (int t = 0; t < nt; t += 2) {
            const bool last = (t == nt - 2);
            const char* a1 = cA + (size_t)(t + 1) * kstep;
            const char* a2 = last ? nA : cA + (size_t)(t + 2) * kstep; const char* b2 = last ? nB : cB + (size_t)(t + 2) * kstep;
            const char* a3 = a2 + kstep; const char* b3 = b2 + kstep;
            if (last && has_next) S.a_ready(nxt);
            if constexpr (Epi::MIDHOOK) { if (t == (nt >> 1)) E.mid(acc, cur, wr, wc, fr, fq); }
            if constexpr (SP2) {
            PG8_LDB(B0, 0, 0); PG8_LDB(B1, 0, 1); PG8_SCHED; PG8_LDA(At, 0, 0); PG8_STAGE(PG8_SA(1, 1), a1 + hstep, voffA);
            PG8_WAIT_V(8); PG8_WAIT_L(0); PG8_BAR; PG8_MMA(0, 0, At, B0); PG8_MMA(0, 1, At, B1); PG8_BAR; PG8_SCHED;
            PG8_LDA(At, 0, 1); PG8_STAGE(PG8_SB(0, 0), b2, voffB); PG8_STAGE(PG8_SB(0, 1), b2 + hstep, voffB); PG8_STAGE(PG8_SA(0, 0), a2, voffA);
            PG8_WAIT_V(8); PG8_WAIT_L(0); PG8_BAR; PG8_MMA(1, 0, At, B0); PG8_MMA(1, 1, At, B1); PG8_BAR; PG8_SCHED;
            PG8_LDB(B0, 1, 0); PG8_LDB(B1, 1, 1); PG8_SCHED; PG8_LDA(At, 1, 0); PG8_STAGE(PG8_SA(0, 1), a2 + hstep, voffA);
            PG8_WAIT_V(8); PG8_WAIT_L(0); PG8_BAR; PG8_MMA(0, 0, At, B0); PG8_MMA(0, 1, At, B1); PG8_BAR; PG8_SCHED;
            PG8_LDA(At, 1, 1); PG8_STAGE(PG8_SB(1, 0), b3, voffB); PG8_STAGE(PG8_SB(1, 1), b3 + hstep, voffB); PG8_STAGE(PG8_SA(1, 0), a3, voffA);
            PG8_WAIT_V(8); PG8_WAIT_L(0); PG8_BAR; PG8_MMA(1, 0, At, B0); PG8_MMA(1, 1, At, B1); PG8_BAR; PG8_SCHED;
            } else {
            PG8_LDB(B0, 0, 0); PG8_SCHED; PG8_LDA(At, 0, 0); PG8_STAGE(PG8_SA(1, 1), a1 + hstep, voffA);
            PG8_WAIT_L(8); PG8_BAR; PG8_WAIT_L(0); PG8_MMA(0, 0, At, B0); PG8_BAR; PG8_SCHED;
            PG8_LDB(B1, 0, 1); PG8_STAGE(PG8_SB(0, 0), b2, voffB);
            PG8_BAR; PG8_WAIT_L(0); PG8_MMA(0, 1, At, B1); PG8_BAR;
            PG8_LDA(At, 0, 1); PG8_STAGE(PG8_SA(0, 0), a2, voffA);
            PG8_BAR; PG8_WAIT_L(0); PG8_MMA(1, 0, At, B0); PG8_BAR; PG8_SCHED;
            PG8_STAGE(PG8_SB(0, 1), b2 + hstep, voffB);
            PG8_WAIT_V(6); PG8_BAR; PG8_MMA(1, 1, At, B1); PG8_BAR;
            PG8_LDB(B0, 1, 0); PG8_SCHED; PG8_LDA(At, 1, 0); PG8_STAGE(PG8_SA(0, 1), a2 + hstep, voffA);
            PG8_WAIT_L(8); PG8_BAR; PG8_WAIT_L(0); PG8_MMA(0, 0, At, B0); PG8_BAR; PG8_SCHED;
            PG8_LDB(B1, 1, 1); PG8_STAGE(PG8_SB(1, 0), b3, voffB);
            PG8_BAR; PG8_WAIT_L(0); PG8_MMA(0, 1, At, B1); PG8_BAR;
            PG8_LDA(At, 1, 1); PG8_STAGE(PG8_SA(1, 0), a3, voffA);
            PG8_BAR; PG8_WAIT_L(0); PG8_MMA(1, 0, At, B0); PG8_BAR; PG8_SCHED;
            PG8_STAGE(PG8_SB(1, 1), b3 + hstep, voffB);
            PG8_WAIT_V(6); PG8_BAR; PG8_MMA(1, 1, At, B1); PG8_BAR;
            }
        }
        if constexpr (ALIGN_EPI) { if (wr == 0) PG8_BAR; }
        if constexpr (!Epi::AFTER_DRAIN) { E(acc, cur, wr, wc, fr, fq); S.done(cur); }
        if (!has_next) break;
#pragma unroll
        for (int a = 0; a < 2; ++a)
#pragma unroll
            for (int b = 0; b < 2; ++b)
#pragma unroll
                for (int m = 0; m < 4; ++m)
#pragma unroll
                    for (int n = 0; n < 2; ++n) acc[a][b][m][n] = (f32x4){0.f, 0.f, 0.f, 0.f};
        cur = nxt; cA = nA; cB = nB; ++ui;
        if constexpr (ALIGN_EPI) { if (wr == 1) PG8_BAR; }
    }
    PG8_WAIT_V(0);
    if constexpr (!ALIGN_EPI) { if (wr == 0) PG8_BAR; }
    PG8_BAR;
    if constexpr (Epi::AFTER_DRAIN) { E.fused(acc, cur, wr, wc, fr, fq, lds, wid, lane); S.done(cur); }
#undef PG8_SA
#undef PG8_SB
#undef PG8_STAGE
#undef PG8_LDA
#undef PG8_LDB
#undef PG8_MMA
#undef PG8_WAIT_V
#undef PG8_WAIT_L
#undef PG8_BAR
#undef PG8_SCHED
}
}

constexpr int D = 1024, SEQ = 4096, NB = 8, DIN = 8192, FF = 4096, DEPTH = 2, CH = 128, NCH = SEQ / CH, NH = 4;
constexpr int HB = 4;
constexpr int MH = HB * SEQ;
constexpr int C_CB = 0, C_CC = 1024, C_CU = 2048, C_Q = 3072, C_K = 3584, C_V = 4096, C_G = 5120;
constexpr size_t MiB = 1u << 20;
constexpr size_t WS_SS = 0;
constexpr size_t WS_W = 2 * MiB;
constexpr size_t W_LAYER = 38 * MiB, W_IN = 0, W_CR = 16 * MiB, W_O = 20 * MiB, W_UP = 22 * MiB, W_DN = 30 * MiB;
constexpr size_t WS_XB = 80 * MiB;
constexpr size_t WS_AB = 112 * MiB;
constexpr size_t WS_KV = WS_AB;
constexpr size_t WS_MG = 176 * MiB;
constexpr size_t WS_ST = 208 * MiB;
constexpr size_t WS_PROJ = 240 * MiB;
constexpr size_t WS_U = WS_PROJ;
constexpr size_t WS_END = 496 * MiB;
constexpr int LDS_BYTES = 147456;
constexpr int NWAVES = 8, NT = 512;

#define LAS __attribute__((address_space(3)))
typedef unsigned short bf16;
typedef unsigned u32x4 __attribute__((ext_vector_type(4)));
typedef unsigned u32x2 __attribute__((ext_vector_type(2)));
typedef float f32x4 __attribute__((ext_vector_type(4)));
typedef short bf16x8 __attribute__((ext_vector_type(8)));
#define LDS_WAIT() asm volatile("s_waitcnt lgkmcnt(0)" ::: "memory")

__device__ __forceinline__ unsigned pk2(float lo, float hi) { return pg8::cvt_pk_bf16(lo, hi); }
__device__ __forceinline__ float bflo(unsigned w) { return __uint_as_float(w << 16); }
__device__ __forceinline__ float bfhi(unsigned w) { return __uint_as_float(w & 0xffff0000u); }
__device__ __forceinline__ float wave_sum(float v) {
#pragma unroll
    for (int o = 1; o < 64; o <<= 1) v += __shfl_xor(v, o);
    return v;
}
__device__ __forceinline__ float ex2(float x) { return __builtin_amdgcn_exp2f(x); }

__device__ __forceinline__ void transpose_item(const float* W, int K, int N, bf16* WT, int ldk, int col_off, const float* kscale, LAS float* scr, int item, int lane) {
    const int nblk = N / 32, kb = item / nblk, nb = item % nblk, k0 = 64 * kb, n0 = 32 * nb;
#pragma unroll 8
    for (int i = 0; i < 32; ++i) { const int kk = 2 * i + (lane >> 5); float v = W[(size_t)(k0 + kk) * N + n0 + (lane & 31)]; if (kscale) v *= kscale[k0 + kk]; scr[kk * 33 + (lane & 31)] = v; }
    LDS_WAIT(); asm volatile("" ::: "memory");
    const int c = lane & 7;
#pragma unroll
    for (int j = 0; j < 4; ++j) { const int n = (lane >> 3) + 8 * j; const LAS float* s = scr + (8 * c) * 33 + n;
        u32x4 o; o.x = pk2(s[0 * 33], s[1 * 33]); o.y = pk2(s[2 * 33], s[3 * 33]); o.z = pk2(s[4 * 33], s[5 * 33]); o.w = pk2(s[6 * 33], s[7 * 33]);
        *(u32x4*)(WT + (size_t)(n0 + n) * ldk + col_off + k0 + 8 * c) = o; }
    LDS_WAIT(); asm volatile("" ::: "memory");
}

constexpr int RS = 136;
__device__ __forceinline__ int ppos(int t) { const int k = t & 31; return (t & ~31) + 8 * ((k >> 2) & 3) + 4 * (k >> 4) + (k & 3); }
__device__ __forceinline__ void ld16(const bf16* p, float (&o)[16]) {
    const u32x4 a = *(const u32x4*)p, b = *(const u32x4*)(p + 8);
#pragma unroll
    for (int i = 0; i < 4; ++i) { o[2 * i] = bflo(a[i]); o[2 * i + 1] = bfhi(a[i]); o[8 + 2 * i] = bflo(b[i]); o[8 + 2 * i + 1] = bfhi(b[i]); }
}
__device__ __forceinline__ void rot_load(const bf16* rowp, int c, float posf, float scale, float (&o1)[16], float (&o2)[16]) {
    float a[16], b[16]; ld16(rowp + 16 * c, a); ld16(rowp + 64 + 16 * c, b);
#pragma unroll
    for (int i = 0; i < 16; ++i) { const float inv = ex2(-(float)(16 * c + i) * 0.20762050593046014f); const float ang = posf * inv;
        double rev = (double)ang * 0.15915494309189535; rev -= __builtin_rint(rev); const float fr = (float)rev;
        const float sn = __builtin_amdgcn_sinf(fr), cs = __builtin_amdgcn_cosf(fr);
        o1[i] = (a[i] * cs - b[i] * sn) * scale; o2[i] = (a[i] * sn + b[i] * cs) * scale; }
}
__device__ __forceinline__ void stage_vt(LAS bf16* Vt, const bf16* vbase, int tid) {
    const int tp = tid >> 3, c = tid & 7, t0 = 2 * tp, p0 = ppos(t0);
    const bf16* v0 = vbase + (size_t)t0 * DIN;
#pragma unroll
    for (int u = 0; u < 4; ++u) { const int dv0 = 8 * (c + 8 * u); const u32x4 a = *(const u32x4*)(v0 + dv0), b = *(const u32x4*)(v0 + DIN + dv0);
#pragma unroll
        for (int e = 0; e < 8; ++e) { const unsigned lo = (e & 1) ? (a[e >> 1] >> 16) : (a[e >> 1] & 0xffffu), hi = (e & 1) ? (b[e >> 1] & 0xffff0000u) : (b[e >> 1] << 16);
            *(LAS unsigned*)(Vt + (dv0 + e) * RS + p0) = lo | hi; } }
}
__device__ __forceinline__ void kv_item(LAS unsigned char* lds, const bf16* proj, const int* pos, float* KV, int rowbase, int h, float log2g, int tid) {
    asm volatile("" : "+v"(tid));
    LAS bf16* Vt = (LAS bf16*)lds; LAS bf16* Kt = Vt + 256 * RS;
    stage_vt(Vt, proj + (size_t)rowbase * DIN + C_V + h * 256, tid);
    { const int t = tid >> 2, c = tid & 3; float o1[16], o2[16];
      rot_load(proj + (size_t)(rowbase + t) * DIN + C_K + h * 128, c, (float)pos[t], ex2(log2g * (float)(127 - t)), o1, o2);
      const int p = ppos(t);
#pragma unroll
      for (int i = 0; i < 16; ++i) { Kt[(16 * c + i) * RS + p] = (bf16)(pk2(o1[i], 0.f) & 0xffffu); Kt[(64 + 16 * c + i) * RS + p] = (bf16)(pk2(o2[i], 0.f) & 0xffffu); } }
    __syncthreads();
    const int w = __builtin_amdgcn_readfirstlane(tid >> 6), l = tid & 63, fr = l & 15, fq = l >> 4;
    f32x4 acc[2][8];
#pragma unroll
    for (int mi = 0; mi < 2; ++mi)
#pragma unroll
        for (int nt = 0; nt < 8; ++nt) acc[mi][nt] = (f32x4){0.f, 0.f, 0.f, 0.f};
#pragma unroll
    for (int s = 0; s < 4; ++s) { bf16x8 a[2];
#pragma unroll
        for (int mi = 0; mi < 2; ++mi) a[mi] = *(const LAS bf16x8*)(Vt + (16 * (2 * w + mi) + fr) * RS + 32 * s + 8 * fq);
#pragma unroll
        for (int nt = 0; nt < 8; ++nt) { const bf16x8 b = *(const LAS bf16x8*)(Kt + (16 * nt + fr) * RS + 32 * s + 8 * fq);
#pragma unroll
            for (int mi = 0; mi < 2; ++mi) acc[mi][nt] = __builtin_amdgcn_mfma_f32_16x16x32_bf16(a[mi], b, acc[mi][nt], 0, 0, 0); } }
#pragma unroll
    for (int mi = 0; mi < 2; ++mi)
#pragma unroll
        for (int nt = 0; nt < 8; ++nt)
#pragma unroll
            for (int r = 0; r < 4; ++r) KV[(size_t)(16 * (2 * w + mi) + 4 * fq + r) * 128 + 16 * nt + fr] = acc[mi][nt][r];
    __syncthreads();
}
__device__ __forceinline__ void ret_item(LAS unsigned char* lds, const bf16* proj, const int* pos, const bf16* St, bf16* AB, int rowbase, int h, float log2g, int tid) {
    asm volatile("" : "+v"(tid));
    LAS bf16* Qs = (LAS bf16*)lds; LAS bf16* Ks = Qs + 128 * RS; LAS bf16* Vt = Ks + 128 * RS;
    stage_vt(Vt, proj + (size_t)rowbase * DIN + C_V + h * 256, tid);
    { const int t = tid >> 2, c = tid & 3; float o1[16], o2[16]; const float posf = (float)pos[t];
      rot_load(proj + (size_t)(rowbase + t) * DIN + C_Q + h * 128, c, posf, 0.08838834764831845f, o1, o2);
      u32x4 w0, w1, w2, w3;
#pragma unroll
      for (int i = 0; i < 4; ++i) { w0[i] = pk2(o1[2 * i], o1[2 * i + 1]); w1[i] = pk2(o1[8 + 2 * i], o1[8 + 2 * i + 1]); w2[i] = pk2(o2[2 * i], o2[2 * i + 1]); w3[i] = pk2(o2[8 + 2 * i], o2[8 + 2 * i + 1]); }
      *(LAS u32x4*)(Qs + t * RS + 16 * c) = w0; *(LAS u32x4*)(Qs + t * RS + 16 * c + 8) = w1; *(LAS u32x4*)(Qs + t * RS + 64 + 16 * c) = w2; *(LAS u32x4*)(Qs + t * RS + 64 + 16 * c + 8) = w3;
      rot_load(proj + (size_t)(rowbase + t) * DIN + C_K + h * 128, c, posf, 1.0f, o1, o2);
#pragma unroll
      for (int i = 0; i < 4; ++i) { w0[i] = pk2(o1[2 * i], o1[2 * i + 1]); w1[i] = pk2(o1[8 + 2 * i], o1[8 + 2 * i + 1]); w2[i] = pk2(o2[2 * i], o2[2 * i + 1]); w3[i] = pk2(o2[8 + 2 * i], o2[8 + 2 * i + 1]); }
      *(LAS u32x4*)(Ks + t * RS + 16 * c) = w0; *(LAS u32x4*)(Ks + t * RS + 16 * c + 8) = w1; *(LAS u32x4*)(Ks + t * RS + 64 + 16 * c) = w2; *(LAS u32x4*)(Ks + t * RS + 64 + 16 * c + 8) = w3; }
    __syncthreads();
    const int w = __builtin_amdgcn_readfirstlane(tid >> 6), l = tid & 63, fr = l & 15, fq = l >> 4;
    bf16x8 qf[4];
#pragma unroll
    for (int s = 0; s < 4; ++s) qf[s] = *(const LAS bf16x8*)(Qs + (16 * w + fr) * RS + 32 * s + 8 * fq);
    f32x4 sc[8];
#pragma unroll
    for (int kt = 0; kt < 8; ++kt) { sc[kt] = (f32x4){0.f, 0.f, 0.f, 0.f};
        if (kt <= w) {
#pragma unroll
            for (int s = 0; s < 4; ++s) { const bf16x8 a = *(const LAS bf16x8*)(Ks + (16 * kt + fr) * RS + 32 * s + 8 * fq); sc[kt] = __builtin_amdgcn_mfma_f32_16x16x32_bf16(a, qf[s], sc[kt], 0, 0, 0); } } }
    const int q = 16 * w + fr;
    bf16x8 pf[4];
#pragma unroll
    for (int s2 = 0; s2 < 4; ++s2) { float v[8];
#pragma unroll
        for (int hh = 0; hh < 2; ++hh)
#pragma unroll
            for (int r = 0; r < 4; ++r) { const int kt = 2 * s2 + hh, d = q - (16 * kt + 4 * fq + r); v[4 * hh + r] = (d >= 0) ? sc[kt][r] * ex2(log2g * (float)d) : 0.f; }
        u32x4 pw; pw.x = pk2(v[0], v[1]); pw.y = pk2(v[2], v[3]); pw.z = pk2(v[4], v[5]); pw.w = pk2(v[6], v[7]); pf[s2] = __builtin_bit_cast(bf16x8, pw); }
    f32x4 accA[16];
#pragma unroll
    for (int mt = 0; mt < 16; ++mt) accA[mt] = (f32x4){0.f, 0.f, 0.f, 0.f};
#pragma unroll
    for (int s2 = 0; s2 < 4; ++s2) { if (s2 <= (w >> 1)) {
#pragma unroll
        for (int mt = 0; mt < 16; ++mt) { const bf16x8 a = *(const LAS bf16x8*)(Vt + (16 * mt + fr) * RS + 32 * s2 + 8 * fq); accA[mt] = __builtin_amdgcn_mfma_f32_16x16x32_bf16(a, pf[s2], accA[mt], 0, 0, 0); } } }
    __syncthreads();
#pragma unroll
    for (int it = 0; it < 8; ++it) { const int idx = tid + it * NT, dv = idx >> 4, ch = idx & 15; *(LAS u32x4*)(Vt + dv * RS + 8 * ch) = *(const u32x4*)(St + dv * 128 + 8 * ch); }
    __syncthreads();
    f32x4 accB[16];
#pragma unroll
    for (int mt = 0; mt < 16; ++mt) accB[mt] = (f32x4){0.f, 0.f, 0.f, 0.f};
#pragma unroll
    for (int s = 0; s < 4; ++s)
#pragma unroll
        for (int mt = 0; mt < 16; ++mt) { const bf16x8 a = *(const LAS bf16x8*)(Vt + (16 * mt + fr) * RS + 32 * s + 8 * fq); accB[mt] = __builtin_amdgcn_mfma_f32_16x16x32_bf16(a, qf[s], accB[mt], 0, 0, 0); }
    const float dq = ex2(log2g * (float)(q + 1));
    float sum = 0.f;
#pragma unroll
    for (int mt = 0; mt < 16; ++mt) { accA[mt] = accA[mt] + accB[mt] * dq; sum += (accA[mt][0] + accA[mt][1]) + (accA[mt][2] + accA[mt][3]); }
    sum += __shfl_xor(sum, 16); sum += __shfl_xor(sum, 32);
    const float mu = sum * (1.0f / 256.0f); float var = 0.f;
#pragma unroll
    for (int mt = 0; mt < 16; ++mt) { accA[mt] = accA[mt] - mu; var += (accA[mt][0] * accA[mt][0] + accA[mt][1] * accA[mt][1]) + (accA[mt][2] * accA[mt][2] + accA[mt][3] * accA[mt][3]); }
    var += __shfl_xor(var, 16); var += __shfl_xor(var, 32);
    const float rstd = rsqrtf(var * (1.0f / 256.0f) + pg8::NORM_EPS);
    const size_t R = (size_t)(rowbase + q);
    const bf16* gp = proj + R * DIN + C_G + h * 256 + 4 * fq; bf16* op = AB + R * 2048 + 1024 + h * 256 + 4 * fq;
#pragma unroll
    for (int mt = 0; mt < 16; ++mt) { const u32x2 g2 = *(const u32x2*)(gp + 16 * mt); const float g0 = bflo(g2.x), g1 = bfhi(g2.x), g2f = bflo(g2.y), g3 = bfhi(g2.y);
        const float y0 = accA[mt][0] * rstd * g0 / (1.f + __expf(-g0)), y1 = accA[mt][1] * rstd * g1 / (1.f + __expf(-g1)), y2 = accA[mt][2] * rstd * g2f / (1.f + __expf(-g2f)), y3 = accA[mt][3] * rstd * g3 / (1.f + __expf(-g3));
        u32x2 o; o.x = pk2(y0, y1); o.y = pk2(y2, y3); *(u32x2*)(op + 16 * mt) = o; }
    __syncthreads();
}
__device__ __forceinline__ void conv_item(const bf16* proj, bf16* AB, const float* cw, int ci, int tid) {
    asm volatile("" : "+v"(tid));
    const int c0 = (tid & 127) * 8, t0 = ci * 64 + (tid >> 7) * 16;
    float w0[8], w1[8], w2[8], z1[8], z2[8];
#pragma unroll
    for (int e = 0; e < 8; ++e) { w0[e] = cw[c0 + e]; w1[e] = cw[1024 + c0 + e]; w2[e] = cw[2048 + c0 + e]; z1[e] = 0.f; z2[e] = 0.f; }
    if ((t0 & (SEQ - 1)) != 0) {
        const bf16* p2 = proj + (size_t)(t0 - 2) * DIN + c0; const bf16* p1 = p2 + DIN;
        const u32x4 c2 = *(const u32x4*)(p2 + C_CC), u2 = *(const u32x4*)(p2 + C_CU), c1 = *(const u32x4*)(p1 + C_CC), u1 = *(const u32x4*)(p1 + C_CU);
#pragma unroll
        for (int i = 0; i < 4; ++i) { z2[2 * i] = bflo(c2[i]) * bflo(u2[i]); z2[2 * i + 1] = bfhi(c2[i]) * bfhi(u2[i]); z1[2 * i] = bflo(c1[i]) * bflo(u1[i]); z1[2 * i + 1] = bfhi(c1[i]) * bfhi(u1[i]); }
    }
#pragma unroll 4
    for (int tt = 0; tt < 16; ++tt) { const bf16* p = proj + (size_t)(t0 + tt) * DIN + c0;
        const u32x4 vb = *(const u32x4*)(p + C_CB), vc = *(const u32x4*)(p + C_CC), vu = *(const u32x4*)(p + C_CU); float z[8], o[8];
#pragma unroll
        for (int i = 0; i < 4; ++i) { z[2 * i] = bflo(vc[i]) * bflo(vu[i]); z[2 * i + 1] = bfhi(vc[i]) * bfhi(vu[i]); }
#pragma unroll
        for (int i = 0; i < 4; ++i) { o[2 * i] = bflo(vb[i]) * (w0[2 * i] * z2[2 * i] + w1[2 * i] * z1[2 * i] + w2[2 * i] * z[2 * i]);
            o[2 * i + 1] = bfhi(vb[i]) * (w0[2 * i + 1] * z2[2 * i + 1] + w1[2 * i + 1] * z1[2 * i + 1] + w2[2 * i + 1] * z[2 * i + 1]); }
        u32x4 ow; ow.x = pk2(o[0], o[1]); ow.y = pk2(o[2], o[3]); ow.z = pk2(o[4], o[5]); ow.w = pk2(o[6], o[7]);
        *(u32x4*)(AB + (size_t)(t0 + tt) * 2048 + c0) = ow;
#pragma unroll
        for (int e = 0; e < 8; ++e) { z2[e] = z1[e]; z1[e] = z[e]; } }
}

struct Args { const float* in[13]; float* out; unsigned char* ws; };
__global__ void __launch_bounds__(NT, 2) hybrid_fwd(Args args) {
    extern __shared__ __attribute__((aligned(16))) unsigned char lds_raw[];
    LAS unsigned char* lds = (LAS unsigned char*)lds_raw;
    cg::grid_group grid = cg::this_grid();
    const int tid = threadIdx.x, lane = tid & 63, wave = __builtin_amdgcn_readfirstlane(tid >> 6);
    const int G = gridDim.x, bx = blockIdx.x;
    const int gw = bx * NWAVES + wave, NGW = G * NWAVES;
    unsigned char* ws = args.ws;
    const float* x_in = args.in[0]; const int* positions = (const int*)args.in[1];
    const float *norm_mix = args.in[2], *w_in = args.in[3], *conv_w = args.in[4], *w_conv_out = args.in[5], *ret_norm = args.in[6], *w_ret_out = args.in[7], *w_o = args.in[8],
                *norm_mlp = args.in[9], *w_up = args.in[10], *w_down = args.in[11], *norm_final = args.in[12];
    float* ssall = (float*)(ws + WS_SS);
    bf16* XB = (bf16*)(ws + WS_XB); bf16* AB = (bf16*)(ws + WS_AB); float* KV = (float*)(ws + WS_KV); bf16* MG = (bf16*)(ws + WS_MG); bf16* ST = (bf16*)(ws + WS_ST);
    bf16* PROJ = (bf16*)(ws + WS_PROJ); bf16* U = (bf16*)(ws + WS_U);

    {
        LAS float* scr = (LAS float*)(lds + wave * 16384);
        constexpr int I_IN = 16 * 256, I_SQ = 16 * 32, I_UP = 16 * 128, I_DN = 64 * 32, I_LAYER = I_IN + 3 * I_SQ + I_UP + I_DN;
        for (int it = gw; it < DEPTH * I_LAYER; it += NGW) {
            const int L = it / I_LAYER; int r = it % I_LAYER; bf16* wl = (bf16*)(ws + WS_W + (size_t)L * W_LAYER);
            if (r < I_IN) { transpose_item(w_in + (size_t)L * D * DIN, D, DIN, (bf16*)((char*)wl + W_IN), D, 0, norm_mix + L * D, scr, r, lane); continue; } r -= I_IN;
            if (r < I_SQ) { transpose_item(w_conv_out + (size_t)L * D * D, D, D, (bf16*)((char*)wl + W_CR), 2048, 0, nullptr, scr, r, lane); continue; } r -= I_SQ;
            if (r < I_SQ) { transpose_item(w_ret_out + (size_t)L * D * D, D, D, (bf16*)((char*)wl + W_CR), 2048, 1024, ret_norm + L * D, scr, r, lane); continue; } r -= I_SQ;
            if (r < I_SQ) { transpose_item(w_o + (size_t)L * D * D, D, D, (bf16*)((char*)wl + W_O), D, 0, nullptr, scr, r, lane); continue; } r -= I_SQ;
            if (r < I_UP) { transpose_item(w_up + (size_t)L * D * FF, D, FF, (bf16*)((char*)wl + W_UP), D, 0, norm_mlp + L * D, scr, r, lane); continue; } r -= I_UP;
            transpose_item(w_down + (size_t)L * FF * D, FF, D, (bf16*)((char*)wl + W_DN), FF, 0, nullptr, scr, r, lane);
        }
        for (int i = bx * NT + tid; i < 2 * 4 * MH; i += G * NT) { const int hf = i / (4 * MH), r = i % (4 * MH); ssall[(size_t)hf * 5 * MH + MH + r] = 0.f; }
    }

    for (int hf = 0; hf < 2; ++hf) {
        float* ss = ssall + (size_t)hf * 5 * MH;
        const float* xh = x_in + (size_t)hf * MH * D; float* outh = args.out + (size_t)hf * MH * D;
        int lnx = lane; asm volatile("" : "+v"(lnx));
        for (int row = gw; row < MH; row += NGW) {
            const f32x4* xr = (const f32x4*)(xh + (size_t)row * D) + lnx; f32x4 v[4]; float s = 0.f;
#pragma unroll
            for (int j = 0; j < 4; ++j) { v[j] = xr[64 * j]; s += (v[j][0] * v[j][0] + v[j][1] * v[j][1]) + (v[j][2] * v[j][2] + v[j][3] * v[j][3]); }
            s = wave_sum(s); if (lnx == 0) ss[row] = s;
            u32x2* o8 = (u32x2*)(XB + (size_t)row * D) + lnx;
#pragma unroll
            for (int j = 0; j < 4; ++j) { u32x2 o; o.x = pk2(v[j][0], v[j][1]); o.y = pk2(v[j][2], v[j][3]); o8[64 * j] = o; }
        }
        grid.sync();
        for (int L = 0; L < DEPTH; ++L) {
            const unsigned char* wl = ws + WS_W + (size_t)L * W_LAYER;
            { pg8::Gemm g{XB, (const bf16*)(wl + W_IN), MH, DIN, D}; pg8::StaticOrder S; S.init(MH, DIN, G, bx);
              pg8::EpiScaleBf16<0> E{PROJ, DIN, ss + (2 * L) * MH};
              pg8::gemm_phase<pg8::EpiScaleBf16<0>, pg8::StaticOrder, true, true>(lds, g, S, E); }
            grid.sync();
            for (int it = bx; it < HB * NH * NCH; it += G) { const int i = it & 31, h = (it >> 5) & 3, bl = it >> 7;
                const float log2g = __log2f(1.0f - ex2(-5.0f - (float)h));
                kv_item(lds, PROJ, positions + (size_t)(hf * HB + bl) * SEQ + i * CH, KV + (size_t)it * 32768, bl * SEQ + i * CH, h, log2g, tid); }
            grid.sync();
            int tsc = tid; asm volatile("" : "+v"(tsc));
            for (int gidx = bx * NT + tsc; gidx < 16 * 8192; gidx += G * NT) { const int pair = gidx >> 13, e = (gidx & 8191) * 4, h = pair & 3;
                const float gC = ex2(128.0f * __log2f(1.0f - ex2(-5.0f - (float)h)));
                f32x4 s = (f32x4){0.f, 0.f, 0.f, 0.f};
#pragma unroll 8
                for (int i = 0; i < NCH; ++i) { const size_t idx = (size_t)(pair * 32 + i) * 32768 + e; u32x2 o; o.x = pk2(s[0], s[1]); o.y = pk2(s[2], s[3]); *(u32x2*)(ST + idx) = o;
                    const f32x4 kv = *(const f32x4*)(KV + idx); s = s * gC + kv; } }
            grid.sync();
            for (int it = bx; it < HB * NH * NCH; it += G) { const int i = it & 31, h = (it >> 5) & 3, bl = it >> 7;
                const float log2g = __log2f(1.0f - ex2(-5.0f - (float)h));
                ret_item(lds, PROJ, positions + (size_t)(hf * HB + bl) * SEQ + i * CH, ST + (size_t)it * 32768, AB, bl * SEQ + i * CH, h, log2g, tid); }
            for (int ci = bx; ci < MH / 64; ci += G) conv_item(PROJ, AB, conv_w + (size_t)L * 3 * D, ci, tid);
            grid.sync();
            { pg8::Gemm g{AB, (const bf16*)(wl + W_CR), MH, D, 2048}; pg8::StaticOrder S; S.init(MH, D, G, bx);
              pg8::EpiMerge E{PROJ, MG};
              pg8::gemm_phase<pg8::EpiMerge, pg8::StaticOrder, true, true>(lds, g, S, E); }
            grid.sync();
            { pg8::Gemm g{MG, (const bf16*)(wl + W_O), MH, D, D}; pg8::StaticOrder S; S.init(MH, D, G, bx);
              pg8::EpiResidual E{L == 0 ? xh : (const float*)outh, outh, XB, ss + (2 * L + 1) * MH};
              pg8::gemm_phase<pg8::EpiResidual, pg8::StaticOrder, true, true>(lds, g, S, E); }
            grid.sync();
            { pg8::Gemm g{XB, (const bf16*)(wl + W_UP), MH, FF, D}; pg8::StaticOrder S; S.init(MH, FF, G, bx);
              pg8::EpiScaleBf16<1> E{U, FF, ss + (2 * L + 1) * MH};
              pg8::gemm_phase<pg8::EpiScaleBf16<1>, pg8::StaticOrder, true, true>(lds, g, S, E); }
            grid.sync();
            { pg8::Gemm g{U, (const bf16*)(wl + W_DN), MH, D, FF}; pg8::StaticOrder S; S.init(MH, D, G, bx);
              pg8::EpiResidual E{outh, outh, XB, ss + (2 * L + 2) * MH};
              pg8::gemm_phase<pg8::EpiResidual, pg8::StaticOrder, true, true>(lds, g, S, E); }
            grid.sync();
        }
        int lnf = lane; asm volatile("" : "+v"(lnf));
        for (int row = gw; row < MH; row += NGW) {
            f32x4* xr = (f32x4*)(outh + (size_t)row * D) + lnf; const f32x4* gr = (const f32x4*)norm_final + lnf;
            const float r = rsqrtf(ss[4 * MH + row] * (1.0f / 1024.0f) + pg8::NORM_EPS);
#pragma unroll
            for (int j = 0; j < 4; ++j) { const f32x4 v = xr[64 * j]; xr[64 * j] = v * r * gr[64 * j]; }
        }
    }
}

extern "C" void kernel_launch(void* const* d_in, const int* in_sizes, int n_in, void* d_out, int out_size, void* d_ws, size_t ws_size, hipStream_t stream) {
    static int grid = 0;
    if (grid == 0) {
        if (n_in != 13 || out_size != NB * SEQ * D || ws_size < WS_END) { fprintf(stderr, "kernel_launch: unexpected shapes (n_in %d, out %d, ws %zu < %zu)\n", n_in, out_size, ws_size, (size_t)WS_END); grid = -1; return; }
        int dev = 0, cus = 0, per_cu = 0;
        (void)hipGetDevice(&dev); (void)hipDeviceGetAttribute(&cus, hipDeviceAttributeMultiprocessorCount, dev);
        if (hipFuncSetAttribute((const void*)hybrid_fwd, hipFuncAttributeMaxDynamicSharedMemorySize, LDS_BYTES) != hipSuccess) { fprintf(stderr, "kernel_launch: hipFuncSetAttribute failed\n"); grid = -1; return; }
        if (hipOccupancyMaxActiveBlocksPerMultiprocessor(&per_cu, (const void*)hybrid_fwd, NT, LDS_BYTES) != hipSuccess || per_cu < 1) { fprintf(stderr, "kernel_launch: occupancy query says %d\n", per_cu); per_cu = 1; }
        (void)hipGetLastError();
        grid = cus * per_cu;
    }
    if (grid < 0) return;
    Args a{};
    for (int i = 0; i < 13; ++i) a.in[i] = (const float*)d_in[i];
    a.out = (float*)d_out; a.ws = (unsigned char*)d_ws;
    void* kargs[] = {&a};
    hipError_t e = hipLaunchCooperativeKernel((const void*)hybrid_fwd, dim3(grid), dim3(NT), kargs, LDS_BYTES, stream);
    if (e != hipSuccess) fprintf(stderr, "kernel_launch: cooperative launch failed: %s (grid %d)\n", hipGetErrorString(e), grid);
}
```

```cpp
#include <hip/hip_runtime.h>
#include <hip/hip_cooperative_groups.h>
#include <cstdio>
#include <cstdint>
namespace cg = cooperative_groups;
namespace pg8 {
#define PG8_LAS __attribute__((address_space(3)))
typedef unsigned short bf16_t;
typedef short bf16x8 __attribute__((ext_vector_type(8)));
typedef float f32x4 __attribute__((ext_vector_type(4)));
typedef unsigned u32x4 __attribute__((ext_vector_type(4)));
constexpr int BM = 256, BK = 64, HALF = 128, HTB = HALF * BK * 2  , STAGE_BYTES = 8 * HTB, NXCD = 8, WGM = 8;

__host__ __device__ __forceinline__ int lds_byte(int r, int c) { const int st = (r >> 4) * 2 + (c >> 5), rr = r & 15, cc = c & 31, ob = rr * 64 + cc * 2; return st * 1024 + (ob ^ (((ob >> 9) & 1) << 5)); }
__host__ __device__ __forceinline__ void stage_rc(int b, int& R, int& C) { const int st = b / 1024, sb = b % 1024, swz = sb ^ (((sb >> 9) & 1) << 5); R = (st >> 1) * 16 + swz / 64; C = (st & 1) * 32 + (swz % 64) / 2; }
__host__ __device__ __forceinline__ int perm32(int rho) { const int n = rho >> 4, i = rho & 15; return 8 * (i >> 2) + 4 * n + (i & 3); }

struct Unit { int pm, pn; };
struct Gemm { const bf16_t* A; const bf16_t* Bt; int M, N, K; };

struct StaticOrder {
    int nM, nN, nwg, G, c;
    __host__ __device__ void init(int M, int N, int G_, int c_) { nM = M / BM; nN = N / BM; nwg = nM * nN; G = G_; c = c_; }
    __host__ __device__ bool next(int i, Unit& u) const {
        const long L = (long)i * G + c; if (L >= nwg) return false;
        int wgid = (int)L; { const int q = nwg / NXCD, r = nwg % NXCD, xcd = wgid % NXCD, off = wgid / NXCD; wgid = (xcd < r ? xcd * (q + 1) : r * (q + 1) + (xcd - r) * q) + off; }
        const int nig = WGM * nN, gid = wgid / nig, fm = gid * WGM, gsz = (nM - fm) < WGM ? (nM - fm) : WGM;
        u.pm = fm + ((wgid % nig) % gsz); u.pn = (wgid % nig) / gsz; return true;
    }
    __device__ __forceinline__ void a_ready(const Unit&) const {}
    __device__ __forceinline__ void done(const Unit&) const {}
};

__device__ __forceinline__ unsigned cvt_pk_bf16(float lo, float hi) { unsigned r; asm volatile("v_cvt_pk_bf16_f32 %0, %1, %2" : "=v"(r) : "v"(lo), "v"(hi)); return r; }
typedef float f32x2 __attribute__((ext_vector_type(2)));

typedef __bf16 bf16x2n __attribute__((ext_vector_type(2)));
__device__ __forceinline__ unsigned cvt_pk_bf16c(float lo, float hi) { const f32x2 v = {lo, hi}; return __builtin_bit_cast(unsigned, __builtin_convertvector(v, bf16x2n)); }

constexpr float NORM_EPS = 1e-6f;
template <int ACT, bool STORE = true, bool ZF = false> struct EpiScaleBf16 {
    static constexpr bool PERM = true, AFTER_DRAIN = false, MIDHOOK = false, HASINIT = false; static constexpr int NSTORES = STORE ? 16 : 0;
    static __device__ __forceinline__ int nstores(const Unit& u) { return STORE ? ((ZF && u.pn >= 4 && u.pn < 12) ? 8 : 16) : 0; }
    bf16_t* O; int ldc; const float* ss; const PG8_LAS float* rtab; int pm0;
    __device__ __forceinline__ void operator()(const f32x4 (&acc)[2][2][4][2], const Unit& u, int wr, int wc, int fr, int fq) const {
        int row0 = u.pm * BM + wr * 64 + fr; asm volatile("" : "+v"(row0)); const int col0 = u.pn * BM + wc * 32 + 8 * fq;
        float rr[8];
        if (u.pm == pm0) {
#pragma unroll
            for (int i = 0; i < 8; ++i) rr[i] = rtab[row0 - u.pm * BM + (i >> 2) * HALF + (i & 3) * 16];
        } else {
#pragma unroll
            for (int i = 0; i < 8; ++i) rr[i] = rsqrtf(ss[row0 + (i >> 2) * HALF + (i & 3) * 16] * (1.0f / 1024.0f) + NORM_EPS);
        }
        if (ZF && u.pn >= 4 && u.pn < 12) {
            const int zc0 = 1024 + (u.pn - 4) * HALF + wc * 32 + 8 * fq;
#pragma unroll
            for (int ai = 0; ai < 2; ++ai)
#pragma unroll
                for (int m = 0; m < 4; ++m) { const int row = row0 + ai * HALF + m * 16; const float r = rr[ai * 4 + m], r2 = r * r;
                    const f32x4 v0 = acc[ai][0][m][0] * acc[ai][1][m][0] * r2, v1 = acc[ai][0][m][1] * acc[ai][1][m][1] * r2;
                    u32x4 w; w.x = cvt_pk_bf16(v0[0], v0[1]); w.y = cvt_pk_bf16(v0[2], v0[3]); w.z = cvt_pk_bf16(v1[0], v1[1]); w.w = cvt_pk_bf16(v1[2], v1[3]);
                    *(u32x4*)(O + (size_t)row * ldc + zc0) = w; }
            return;
        }
#pragma unroll
        for (int ai = 0; ai < 2; ++ai)
#pragma unroll
            for (int m = 0; m < 4; ++m) { const int row = row0 + ai * HALF + m * 16; const float r = rr[ai * 4 + m];
                bf16_t* rowp = O + (size_t)row * ldc + col0;
#pragma unroll
                for (int bj = 0; bj < 2; ++bj) { f32x4 v0 = acc[ai][bj][m][0] * r, v1 = acc[ai][bj][m][1] * r;
                    if (ACT == 1) {
#pragma unroll
                        for (int j = 0; j < 4; ++j) { const float a = fmaxf(v0[j], 0.f), b = fmaxf(v1[j], 0.f); v0[j] = a * a; v1[j] = b * b; } }
                    u32x4 w; w.x = cvt_pk_bf16(v0[0], v0[1]); w.y = cvt_pk_bf16(v0[2], v0[3]); w.z = cvt_pk_bf16(v1[0], v1[1]); w.w = cvt_pk_bf16(v1[2], v1[3]);
                    if (STORE) *(u32x4*)(rowp + bj * HALF) = w; } }
    }
};
__device__ __forceinline__ float bf_lo(unsigned w) { return __uint_as_float(w << 16); }
__device__ __forceinline__ float bf_hi(unsigned w) { return __uint_as_float(w & 0xffff0000u); }
__device__ __forceinline__ float clamp30(float x) { return fminf(fmaxf(x, -30.f), 30.f); }
struct EpiMerge {
    static constexpr bool PERM = true, AFTER_DRAIN = false, MIDHOOK = true, HASINIT = false; static constexpr int NSTORES = 0;
    static __device__ __forceinline__ int nstores(const Unit&) { return 0; }
    const bf16_t* proj; bf16_t* O;
    __device__ __forceinline__ void mid(f32x4 (&acc)[2][2][4][2], const Unit& u, int wr, int wc, int fr, int fq) const {
        int row0 = u.pm * BM + wr * 64 + fr; asm volatile("" : "+v"(row0)); const int col0 = u.pn * BM + wc * 32 + 8 * fq;
#pragma unroll
        for (int ai = 0; ai < 2; ++ai) { u32x4 ga[4][2], gb[4][2];
#pragma unroll
            for (int m = 0; m < 4; ++m) { const bf16_t* rowp = proj + (size_t)(row0 + ai * HALF + m * 16) * 8192 + col0;
#pragma unroll
                for (int bj = 0; bj < 2; ++bj) { ga[m][bj] = *(const u32x4*)(rowp + 6144 + bj * HALF); gb[m][bj] = *(const u32x4*)(rowp + 7168 + bj * HALF); } }
#pragma unroll
            for (int m = 0; m < 4; ++m) {
#pragma unroll
                for (int bj = 0; bj < 2; ++bj) { const u32x4 a = ga[m][bj], b = gb[m][bj];
#pragma unroll
                    for (int j = 0; j < 4; ++j) { const float ea0 = __expf(-clamp30(bf_lo(a[j]))), ea1 = __expf(-clamp30(bf_hi(a[j]))), eb0 = __expf(-clamp30(bf_lo(b[j]))), eb1 = __expf(-clamp30(bf_hi(b[j])));
                        const float r0 = (1.f + eb0) * __builtin_amdgcn_rcpf(1.f + ea0), r1 = (1.f + eb1) * __builtin_amdgcn_rcpf(1.f + ea1);
                        acc[ai][bj][m][j >> 1][(j & 1) * 2] *= r0; acc[ai][bj][m][j >> 1][(j & 1) * 2 + 1] *= r1; } } }
            asm volatile("" ::: "memory"); }
    }
    __device__ __forceinline__ void operator()(const f32x4 (&acc)[2][2][4][2], const Unit& u, int wr, int wc, int fr, int fq) const {
        int row0 = u.pm * BM + wr * 64 + fr; asm volatile("" : "+v"(row0)); const int col0 = u.pn * BM + wc * 32 + 8 * fq;
        u32x4 gb[8][2];
#pragma unroll
        for (int i = 0; i < 8; ++i) { const bf16_t* rowp = proj + (size_t)(row0 + (i >> 2) * HALF + (i & 3) * 16) * 8192 + 7168 + col0; gb[i][0] = *(const u32x4*)rowp; gb[i][1] = *(const u32x4*)(rowp + HALF); }
#pragma unroll
        for (int ai = 0; ai < 2; ++ai)
#pragma unroll
            for (int m = 0; m < 4; ++m) { const size_t row = (size_t)(row0 + ai * HALF + m * 16);
#pragma unroll
                for (int bj = 0; bj < 2; ++bj) { const u32x4 b = gb[ai * 4 + m][bj]; float v[8];
#pragma unroll
                    for (int j = 0; j < 4; ++j) { const float s0 = __builtin_amdgcn_rcpf(1.f + __expf(-clamp30(bf_lo(b[j])))), s1 = __builtin_amdgcn_rcpf(1.f + __expf(-clamp30(bf_hi(b[j]))));
                        v[2 * j] = acc[ai][bj][m][j >> 1][(j & 1) * 2] * s0; v[2 * j + 1] = acc[ai][bj][m][j >> 1][(j & 1) * 2 + 1] * s1; }
                    u32x4 w; w.x = cvt_pk_bf16(v[0], v[1]); w.y = cvt_pk_bf16(v[2], v[3]); w.z = cvt_pk_bf16(v[4], v[5]); w.w = cvt_pk_bf16(v[6], v[7]);
                    *(u32x4*)(O + row * 1024 + col0 + bj * HALF) = w; } }
    }
};
struct EpiResidual {
    static constexpr bool PERM = false, AFTER_DRAIN = false, MIDHOOK = false, HASINIT = true; static constexpr int NSTORES = 0;
    static __device__ __forceinline__ int nstores(const Unit&) { return 0; }
    const float* base; float* out; bf16_t* xb; float* ss;
    __device__ __forceinline__ void init(f32x4 (&acc)[2][2][4][2], const Unit& u, int wr, int wc, int fr, int fq) const {
        int row0 = u.pm * BM + wr * 64 + fr; asm volatile("" : "+v"(row0)); const int col0 = u.pn * BM + wc * 32 + 4 * fq;
#pragma unroll
        for (int ai = 0; ai < 2; ++ai)
#pragma unroll
            for (int m = 0; m < 4; ++m) { const size_t off = (size_t)(row0 + ai * HALF + m * 16) * 1024 + col0;
#pragma unroll
                for (int bj = 0; bj < 2; ++bj)
#pragma unroll
                    for (int n = 0; n < 2; ++n) acc[ai][bj][m][n] = *(const f32x4*)(base + off + bj * HALF + n * 16); }
    }
    __device__ __forceinline__ void operator()(const f32x4 (&acc)[2][2][4][2], const Unit& u, int wr, int wc, int fr, int fq) const {
        typedef unsigned u32x2v __attribute__((ext_vector_type(2)));
        int row0 = u.pm * BM + wr * 64 + fr; asm volatile("" : "+v"(row0)); const int col0 = u.pn * BM + wc * 32 + 4 * fq;
#pragma unroll
        for (int ai = 0; ai < 2; ++ai)
#pragma unroll
            for (int m = 0; m < 4; ++m) { const int row = row0 + ai * HALF + m * 16; const size_t off = (size_t)row * 1024 + col0; float s = 0.f;
#pragma unroll
                for (int bj = 0; bj < 2; ++bj)
#pragma unroll
                    for (int n = 0; n < 2; ++n) { const f32x4 v = acc[ai][bj][m][n] * 1.0f;
                        *(f32x4*)(out + off + bj * HALF + n * 16) = v; u32x2v w; w.x = cvt_pk_bf16c(v[0], v[1]); w.y = cvt_pk_bf16c(v[2], v[3]);
                        if (xb) *(u32x2v*)(xb + off + bj * HALF + n * 16) = w; s += (v[0] * v[0] + v[1] * v[1]) + (v[2] * v[2] + v[3] * v[3]); }
                s += __shfl_xor(s, 16); s += __shfl_xor(s, 32);
                if (fq == 0) __hip_atomic_fetch_add(ss + row, s, __ATOMIC_RELAXED, __HIP_MEMORY_SCOPE_AGENT); }
    }
};

template <class Epi, class Sched, bool ALIGN_EPI = false, bool SP2 = false>
__device__ __forceinline__ void gemm_phase(PG8_LAS unsigned char* lds, const Gemm g, const Sched& S, const Epi& E) {
    int tid_ = threadIdx.x; asm volatile("" : "+v"(tid_));
    const int tid = tid_, wid = __builtin_amdgcn_readfirstlane(tid >> 6), lane = tid & 63, wr = wid >> 2, wc = wid & 3, fr = lane & 15, fq = lane >> 4;
    const int K = g.K, nt = K / BK;
    unsigned voffA[2], voffB[2];
#pragma unroll
    for (int i = 0; i < 2; ++i) { int R, C; stage_rc(tid * 16 + i * 8192, R, C); const int Rb = Epi::PERM ? ((R & ~31) + perm32(R & 31)) : R;
        voffA[i] = (unsigned)(R * K + C) * 2u; voffB[i] = (unsigned)(Rb * K + C) * 2u; }
    const size_t kstep = (size_t)(BK * 2);
    const size_t hstep = (size_t)HALF * K * 2;
    const size_t tstep = 2 * hstep;
    const unsigned ldsw = (unsigned)wid * 1024u;
    const int aoff = lds_byte(wr * 64 + fr, fq * 8), boff = lds_byte(wc * 32 + fr, fq * 8);
#define PG8_SA(b, h) (((b) * 2 + (h)) * HTB)
#define PG8_SB(b, h) ((4 + (b) * 2 + (h)) * HTB)
#define PG8_STAGE(bufoff, gbase, voff) do { _Pragma("unroll") for (int _i = 0; _i < 2; ++_i) \
        __builtin_amdgcn_global_load_lds((const unsigned*)((const char*)(gbase) + (voff)[_i]), (PG8_LAS unsigned*)(lds + (bufoff) + ldsw + _i * 8192), 16, 0, 0); } while (0)
#define PG8_LDA(dst, b, h) do { _Pragma("unroll") for (int m = 0; m < 4; ++m) _Pragma("unroll") for (int k = 0; k < 2; ++k) dst[m][k] = *(const PG8_LAS bf16x8*)(lds + PG8_SA(b, h) + aoff + m * 2048 + k * 1024); } while (0)
#define PG8_LDB(dst, b, h) do { _Pragma("unroll") for (int n = 0; n < 2; ++n) _Pragma("unroll") for (int k = 0; k < 2; ++k) dst[n][k] = *(const PG8_LAS bf16x8*)(lds + PG8_SB(b, h) + boff + n * 2048 + k * 1024); } while (0)
#define PG8_MMA(ai, bj, At, Bt) do { __builtin_amdgcn_s_setprio(1); _Pragma("unroll") for (int m = 0; m < 4; ++m) _Pragma("unroll") for (int n = 0; n < 2; ++n) _Pragma("unroll") for (int k = 0; k < 2; ++k) \
        acc[ai][bj][m][n] = __builtin_amdgcn_mfma_f32_16x16x32_bf16(Bt[n][k], At[m][k], acc[ai][bj][m][n], 0, 0, 0); __builtin_amdgcn_s_setprio(0); } while (0)
#define PG8_WAIT_V(n) asm volatile("s_waitcnt vmcnt(" #n ")" ::: "memory")
#define PG8_WAIT_L(n) asm volatile("s_waitcnt lgkmcnt(" #n ")" ::: "memory")
#define PG8_BAR __builtin_amdgcn_s_barrier()
#define PG8_SCHED __builtin_amdgcn_sched_barrier(0)
    Unit cur, nxt; int ui = 0;
    if (!S.next(0, cur)) return;
    f32x4 acc[2][2][4][2];
    if constexpr (Epi::HASINIT) E.init(acc, cur, wr, wc, fr, fq);
    else {
#pragma unroll
    for (int a = 0; a < 2; ++a)
#pragma unroll
        for (int b = 0; b < 2; ++b)
#pragma unroll
            for (int m = 0; m < 4; ++m)
#pragma unroll
                for (int n = 0; n < 2; ++n) acc[a][b][m][n] = (f32x4){0.f, 0.f, 0.f, 0.f};
    }
    bf16x8 At[4][2], B0[2][2], B1[2][2];
    const char* cA = (const char*)g.A + (size_t)cur.pm * tstep; const char* cB = (const char*)g.Bt + (size_t)cur.pn * tstep;
    S.a_ready(cur);
    if constexpr (SP2) {
        PG8_STAGE(PG8_SB(0, 0), cB, voffB); PG8_STAGE(PG8_SB(0, 1), cB + hstep, voffB); PG8_STAGE(PG8_SA(0, 0), cA, voffA); PG8_STAGE(PG8_SA(0, 1), cA + hstep, voffA);
        if (wr == 1) PG8_BAR;
        PG8_WAIT_V(2); PG8_BAR;
        PG8_STAGE(PG8_SB(1, 0), cB + kstep, voffB); PG8_STAGE(PG8_SA(1, 0), cA + kstep, voffA); PG8_STAGE(PG8_SB(1, 1), cB + hstep + kstep, voffB);
        PG8_WAIT_V(6); PG8_BAR;
    } else {
        PG8_STAGE(PG8_SB(0, 0), cB, voffB); PG8_STAGE(PG8_SA(0, 0), cA, voffA); PG8_STAGE(PG8_SB(0, 1), cB + hstep, voffB); PG8_STAGE(PG8_SA(0, 1), cA + hstep, voffA);
        if (wr == 1) PG8_BAR;
        PG8_WAIT_V(4); PG8_BAR;
        PG8_STAGE(PG8_SB(1, 0), cB + kstep, voffB); PG8_STAGE(PG8_SA(1, 0), cA + kstep, voffA); PG8_STAGE(PG8_SB(1, 1), cB + hstep + kstep, voffB);
        PG8_WAIT_V(6); PG8_BAR;
    }
    for (;;) {
        const bool has_next = S.next(ui + 1, nxt);
        const char* nA = has_next ? (const char*)g.A + (size_t)nxt.pm * tstep : cA; const char* nB = has_next ? (const char*)g.Bt + (size_t)nxt.pn * tstep : cB;
        for (int t = 0; t < nt; t += 2) {
            const bool last = (t == nt - 2);
            const char* a1 = cA + (size_t)(t + 1) * kstep;
            const char* a2 = last ? nA : cA + (size_t)(t + 2) * kstep; const char* b2 = last ? nB : cB + (size_t)(t + 2) * kstep;
            const char* a3 = a2 + kstep; const char* b3 = b2 + kstep;
            if (last && has_next) S.a_ready(nxt);
            if constexpr (Epi::MIDHOOK) { if (t == (nt >> 1)) E.mid(acc, cur, wr, wc, fr, fq); }
            if constexpr (SP2) {
            PG8_LDB(B0, 0, 0); PG8_LDB(B1, 0, 1); PG8_SCHED; PG8_LDA(At, 0, 0); PG8_STAGE(PG8_SA(1, 1), a1 + hstep, voffA);
            PG8_WAIT_V(8); PG8_WAIT_L(0); PG8_BAR; PG8_MMA(0, 0, At, B0); PG8_MMA(0, 1, At, B1); PG8_BAR; PG8_SCHED;
            PG8_LDA(At, 0, 1); PG8_STAGE(PG8_SB(0, 0), b2, voffB); PG8_STAGE(PG8_SB(0, 1), b2 + hstep, voffB); PG8_STAGE(PG8_SA(0, 0), a2, voffA);
            PG8_WAIT_V(8); PG8_WAIT_L(0); PG8_BAR; PG8_MMA(1, 0, At, B0); PG8_MMA(1, 1, At, B1); PG8_BAR; PG8_SCHED;
            PG8_LDB(B0, 1, 0); PG8_LDB(B1, 1, 1); PG8_SCHED; PG8_LDA(At, 1, 0); PG8_STAGE(PG8_SA(0, 1), a2 + hstep, voffA);
            PG8_WAIT_V(8); PG8_WAIT_L(0); PG8_BAR; PG8_MMA(0, 0, At, B0); PG8_MMA(0, 1, At, B1); PG8_BAR; PG8_SCHED;
            PG8_LDA(At, 1, 1); PG8_STAGE(PG8_SB(1, 0), b3, voffB); PG8_STAGE(PG8_SB(1, 1), b3 + hstep, voffB); PG8_STAGE(PG8_SA(1, 0), a3, voffA);
            PG8_WAIT_V(8); PG8_WAIT_L(0); PG8_BAR; PG8_MMA(1, 0, At, B0); PG8_MMA(1, 1, At, B1); PG8_BAR; PG8_SCHED;
            } else {
            PG8_LDB(B0, 0, 0); PG8_SCHED; PG8_LDA(At, 0, 0); PG8_STAGE(PG8_SA(1, 1), a1 + hstep, voffA);
            PG8_WAIT_L(8); PG8_BAR; PG8_WAIT_L(0); PG8_MMA(0, 0, At, B0); PG8_BAR; PG8_SCHED;
            PG8_LDB(B1, 0, 1); PG8_STAGE(PG8_SB(0, 0), b2, voffB);
            PG8_BAR; PG8_WAIT_L(0); PG8_MMA(0, 1, At, B1); PG8_BAR;
            PG8_LDA(At, 0, 1); PG8_STAGE(PG8_SA(0, 0), a2, voffA);
            PG8_BAR; PG8_WAIT_L(0); PG8_MMA(1, 0, At, B0); PG8_BAR; PG8_SCHED;
            PG8_STAGE(PG8_SB(0, 1), b2 + hstep, voffB);
            PG8_WAIT_V(6); PG8_BAR; PG8_MMA(1, 1, At, B1); PG8_BAR;
            PG8_LDB(B0, 1, 0); PG8_SCHED; PG8_LDA(At, 1, 0); PG8_STAGE(PG8_SA(0, 1), a2 + hstep, voffA);
            PG8_WAIT_L(8); PG8_BAR; PG8_WAIT_L(0); PG8_MMA(0, 0, At, B0); PG8_BAR; PG8_SCHED;
            PG8_LDB(B1, 1, 1); PG8_STAGE(PG8_SB(1, 0), b3, voffB);
            PG8_BAR; PG8_WAIT_L(0); PG8_MMA(0, 1, At, B1); PG8_BAR;
            PG8_LDA(At, 1, 1); PG8_STAGE(PG8_SA(1, 0), a3, voffA);
            PG8_BAR; PG8_WAIT_L(0); PG8_MMA(1, 0, At, B0); PG8_BAR; PG8_SCHED;
            PG8_STAGE(PG8_SB(1, 1), b3 + hstep, voffB);
            PG8_WAIT_V(6); PG8_BAR; PG8_MMA(1, 1, At, B1); PG8_BAR;
            }
        }
        if constexpr (ALIGN_EPI) { if (wr == 0) PG8_BAR; }
        if constexpr (!Epi::AFTER_DRAIN) { E(acc, cur, wr, wc, fr, fq); S.done(cur); }
        if (!has_next) break;
        if constexpr (Epi::HASINIT) E.init(acc, nxt, wr, wc, fr, fq);
        else {
#pragma unroll
        for (int a = 0; a < 2; ++a)
#pragma unroll
            for (int b = 0; b < 2; ++b)
#pragma unroll
                for (int m = 0; m < 4; ++m)
#pragma unroll
                    for (int n = 0; n < 2; ++n) acc[a][b][m][n] = (f32x4){0.f, 0.f, 0.f, 0.f};
        }
        cur = nxt; cA = nA; cB = nB; ++ui;
        if constexpr (ALIGN_EPI) { if (wr == 1) PG8_BAR; }
    }
    PG8_WAIT_V(0);
    if constexpr (!ALIGN_EPI) { if (wr == 0) PG8_BAR; }
    PG8_BAR;
    if constexpr (Epi::AFTER_DRAIN) { E.fused(acc, cur, wr, wc, fr, fq, lds, wid, lane); S.done(cur); }
#undef PG8_SA
#undef PG8_SB
#undef PG8_STAGE
#undef PG8_LDA
#undef PG8_LDB
#undef PG8_MMA
#undef PG8_WAIT_V
#undef PG8_WAIT_L
#undef PG8_BAR
#undef PG8_SCHED
}
}

constexpr int D = 1024, SEQ = 4096, NB = 8, DIN = 8192, FF = 4096, DEPTH = 2, CH = 128, NCH = SEQ / CH, NH = 4;
constexpr int HB = 4;
constexpr int MH = HB * SEQ;
constexpr int C_CB = 0, C_CC = 1024, C_CU = 2048, C_Q = 3072, C_K = 3584, C_V = 4096, C_G = 5120;
constexpr size_t MiB = 1u << 20;
constexpr size_t WS_SS = 0;
constexpr size_t WS_BAR = 1 * MiB, BAR_BYTES = 16384;
constexpr size_t WS_W = 2 * MiB;
constexpr size_t W_LAYER = 38 * MiB, W_IN = 0, W_CR = 16 * MiB, W_O = 20 * MiB, W_UP = 22 * MiB, W_DN = 30 * MiB;
constexpr size_t WS_XB = 80 * MiB;
constexpr size_t WS_AB = 112 * MiB;
constexpr size_t WS_KV = WS_AB;
constexpr size_t WS_MG = 176 * MiB;
constexpr size_t WS_ST = 208 * MiB;
constexpr size_t WS_PROJ = 240 * MiB;
constexpr size_t WS_U = WS_PROJ;
constexpr size_t WS_ROT = 496 * MiB;
constexpr size_t WS_END = 504 * MiB;
constexpr int LDS_BYTES = 147456;
constexpr int NWAVES = 8, NT = 512;

#define LAS __attribute__((address_space(3)))
typedef unsigned short bf16;
typedef unsigned u32x4 __attribute__((ext_vector_type(4)));
typedef unsigned u32x2 __attribute__((ext_vector_type(2)));
typedef float f32x4 __attribute__((ext_vector_type(4)));
typedef short bf16x8 __attribute__((ext_vector_type(8)));
#define LDS_WAIT() asm volatile("s_waitcnt lgkmcnt(0)" ::: "memory")

__device__ __forceinline__ unsigned pk2(float lo, float hi) { return pg8::cvt_pk_bf16(lo, hi); }
typedef float f32x2c __attribute__((ext_vector_type(2)));
typedef __bf16 bf16x2c __attribute__((ext_vector_type(2)));
__device__ __forceinline__ unsigned pk2c(float lo, float hi) { const f32x2c v = {lo, hi}; return __builtin_bit_cast(unsigned, __builtin_convertvector(v, bf16x2c)); }
__device__ __forceinline__ float bflo(unsigned w) { return __uint_as_float(w << 16); }
__device__ __forceinline__ float bfhi(unsigned w) { return __uint_as_float(w & 0xffff0000u); }
__device__ __forceinline__ float wave_sum(float v) {
#pragma unroll
    for (int o = 1; o < 64; o <<= 1) v += __shfl_xor(v, o);
    return v;
}
__device__ __forceinline__ float ex2(float x) { return __builtin_amdgcn_exp2f(x); }

__device__ __forceinline__ void transpose_item(const float* W, int K, int N, bf16* WT, int ldk, int col_off, const float* kscale, LAS float* scr, int item, int lane, bool zmap = false) {
    const int nblk = N / 64, kb = item / nblk, nb = item % nblk, k0 = 64 * kb, n0 = 64 * nb;
    int nd0 = n0;
    if (zmap && n0 >= 1024 && n0 < 3072) { const int ch = (n0 - 1024) & 1023; nd0 = 1024 + 256 * (ch >> 7) + (n0 >= 2048 ? 128 : 0) + (ch & 127); }
    const int n4 = (lane & 15) * 4;
#pragma unroll 8
    for (int i = 0; i < 16; ++i) { const int kk = 4 * i + (lane >> 4); f32x4 v = *(const f32x4*)(W + (size_t)(k0 + kk) * N + n0 + n4); if (kscale) v = v * kscale[k0 + kk];
        LAS float* d = scr + kk * 65 + n4; d[0] = v[0]; d[1] = v[1]; d[2] = v[2]; d[3] = v[3]; }
    LDS_WAIT(); asm volatile("" ::: "memory");
    const int c = lane & 7;
#pragma unroll
    for (int j = 0; j < 8; ++j) { const int n = (lane >> 3) + 8 * j; const LAS float* s = scr + (8 * c) * 65 + n;
        u32x4 o; o.x = pk2(s[0 * 65], s[1 * 65]); o.y = pk2(s[2 * 65], s[3 * 65]); o.z = pk2(s[4 * 65], s[5 * 65]); o.w = pk2(s[6 * 65], s[7 * 65]);
        *(u32x4*)(WT + (size_t)(nd0 + n) * ldk + col_off + k0 + 8 * c) = o; }
    LDS_WAIT(); asm volatile("" ::: "memory");
}

constexpr int RS = 136;
__device__ __forceinline__ int ppos(int t) { const int k = t & 31; return (t & ~31) + 8 * ((k >> 2) & 3) + 4 * (k >> 4) + (k & 3); }
struct RawRow { u32x4 a0, a1, b0, b1; };
struct RawV { u32x4 a[4], b[4]; };
struct RawCs { f32x4 t[8]; };
__device__ __forceinline__ RawRow ld_row(const bf16* rowp, int c) { RawRow r; r.a0 = *(const u32x4*)(rowp + 16 * c); r.a1 = *(const u32x4*)(rowp + 16 * c + 8); r.b0 = *(const u32x4*)(rowp + 64 + 16 * c); r.b1 = *(const u32x4*)(rowp + 64 + 16 * c + 8); return r; }
__device__ __forceinline__ RawCs ld_cs(const float* cs, int c) { RawCs r; const f32x4* tp = (const f32x4*)(cs + 32 * c);
#pragma unroll
    for (int i = 0; i < 8; ++i) r.t[i] = tp[i];
    return r; }
__device__ __forceinline__ RawV ld_v(const bf16* vbase, int tid) { RawV r; const int tp = tid >> 3, c = tid & 7; const bf16* v0 = vbase + (size_t)(2 * tp) * DIN;
#pragma unroll
    for (int u = 0; u < 4; ++u) { const int dv0 = 8 * (c + 8 * u); r.a[u] = *(const u32x4*)(v0 + dv0); r.b[u] = *(const u32x4*)(v0 + DIN + dv0); }
    return r; }
__device__ __forceinline__ void unpack16(const u32x4 a, const u32x4 b, float (&o)[16]) {
#pragma unroll
    for (int i = 0; i < 4; ++i) { o[2 * i] = bflo(a[i]); o[2 * i + 1] = bfhi(a[i]); o[8 + 2 * i] = bflo(b[i]); o[8 + 2 * i + 1] = bfhi(b[i]); }
}
__device__ __forceinline__ void rot_apply(const RawRow& rw, const RawCs& cs, float scale, float (&o1)[16], float (&o2)[16]) {
    float a[16], b[16]; unpack16(rw.a0, rw.a1, a); unpack16(rw.b0, rw.b1, b);
#pragma unroll
    for (int i = 0; i < 8; ++i) { const f32x4 t = cs.t[i];
        o1[2 * i] = (a[2 * i] * t[0] - b[2 * i] * t[1]) * scale; o2[2 * i] = (a[2 * i] * t[1] + b[2 * i] * t[0]) * scale;
        o1[2 * i + 1] = (a[2 * i + 1] * t[2] - b[2 * i + 1] * t[3]) * scale; o2[2 * i + 1] = (a[2 * i + 1] * t[3] + b[2 * i + 1] * t[2]) * scale; }
}
__device__ __forceinline__ void stage_vt(LAS bf16* Vt, const RawV& rv, int tid) {
    const int tp = tid >> 3, c = tid & 7, p0 = ppos(2 * tp);
#pragma unroll
    for (int u = 0; u < 4; ++u) { const int dv0 = 8 * (c + 8 * u); const u32x4 a = rv.a[u], b = rv.b[u];
#pragma unroll
        for (int e = 0; e < 8; ++e) { const unsigned lo = (e & 1) ? (a[e >> 1] >> 16) : (a[e >> 1] & 0xffffu), hi = (e & 1) ? (b[e >> 1] & 0xffff0000u) : (b[e >> 1] << 16);
            *(LAS unsigned*)(Vt + (dv0 + e) * RS + p0) = lo | hi; } }
}
__device__ __forceinline__ void kv_item(LAS unsigned char* lds, const bf16* proj, const float* rot, bf16* KV, int rowbase, int h, float log2g, int tid) {
    asm volatile("" : "+v"(tid));
    LAS bf16* Vt = (LAS bf16*)lds; LAS bf16* Kt = Vt + 256 * RS;
    const RawV rv = ld_v(proj + (size_t)rowbase * DIN + C_V + h * 256, tid);
    const RawRow rk = ld_row(proj + (size_t)(rowbase + (tid >> 2)) * DIN + C_K + h * 128, tid & 3);
    const RawCs rc = ld_cs(rot + (size_t)(rowbase + (tid >> 2)) * 128, tid & 3);
    stage_vt(Vt, rv, tid);
    { const int t = tid >> 2, c = tid & 3; float o1[16], o2[16];
      rot_apply(rk, rc, ex2(log2g * (float)(127 - t)), o1, o2);
      const int p = ppos(t);
#pragma unroll
      for (int i = 0; i < 16; ++i) { Kt[(16 * c + i) * RS + p] = (bf16)(pk2(o1[i], 0.f) & 0xffffu); Kt[(64 + 16 * c + i) * RS + p] = (bf16)(pk2(o2[i], 0.f) & 0xffffu); } }
    __syncthreads();
    const int w = __builtin_amdgcn_readfirstlane(tid >> 6), l = tid & 63, fr = l & 15, fq = l >> 4;
    f32x4 acc[2][8];
#pragma unroll
    for (int mi = 0; mi < 2; ++mi)
#pragma unroll
        for (int nt = 0; nt < 8; ++nt) acc[mi][nt] = (f32x4){0.f, 0.f, 0.f, 0.f};
#pragma unroll
    for (int s = 0; s < 4; ++s) { bf16x8 a[2];
#pragma unroll
        for (int mi = 0; mi < 2; ++mi) a[mi] = *(const LAS bf16x8*)(Vt + (16 * (2 * w + mi) + fr) * RS + 32 * s + 8 * fq);
#pragma unroll
        for (int nt = 0; nt < 8; ++nt) { const bf16x8 b = *(const LAS bf16x8*)(Kt + (16 * nt + fr) * RS + 32 * s + 8 * fq);
#pragma unroll
            for (int mi = 0; mi < 2; ++mi) acc[mi][nt] = __builtin_amdgcn_mfma_f32_16x16x32_bf16(b, a[mi], acc[mi][nt], 0, 0, 0); } }
#pragma unroll
    for (int mi = 0; mi < 2; ++mi)
#pragma unroll
        for (int nt = 0; nt < 8; ++nt)
            { u32x2 o; o.x = pk2c(acc[mi][nt][0], acc[mi][nt][1]); o.y = pk2c(acc[mi][nt][2], acc[mi][nt][3]); *(u32x2*)(KV + (size_t)(16 * (2 * w + mi) + fr) * 128 + 16 * nt + 4 * fq) = o; }
    __syncthreads();
}
__device__ __forceinline__ void ret_item(LAS unsigned char* lds, const bf16* proj, const float* rot, const bf16* St, bf16* AB, int rowbase, int h, float log2g, int tid) {
    asm volatile("" : "+v"(tid));
    LAS bf16* Qs = (LAS bf16*)lds; LAS bf16* Ks = Qs + 128 * RS; LAS bf16* Vt = Ks + 128 * RS;
    u32x4 stp[8];
#pragma unroll
    for (int it = 0; it < 8; ++it) { const int idx = tid + it * NT; stp[it] = *(const u32x4*)(St + (idx >> 4) * 128 + 8 * (idx & 15)); }
    const RawV rv = ld_v(proj + (size_t)rowbase * DIN + C_V + h * 256, tid);
    const RawRow rq = ld_row(proj + (size_t)(rowbase + (tid >> 2)) * DIN + C_Q + h * 128, tid & 3);
    const RawRow rk = ld_row(proj + (size_t)(rowbase + (tid >> 2)) * DIN + C_K + h * 128, tid & 3);
    const RawCs rc = ld_cs(rot + (size_t)(rowbase + (tid >> 2)) * 128, tid & 3);
    stage_vt(Vt, rv, tid);
    { const int t = tid >> 2, c = tid & 3; float o1[16], o2[16];
      rot_apply(rq, rc, 0.08838834764831845f, o1, o2);
      u32x4 w0, w1, w2, w3;
#pragma unroll
      for (int i = 0; i < 4; ++i) { w0[i] = pk2(o1[2 * i], o1[2 * i + 1]); w1[i] = pk2(o1[8 + 2 * i], o1[8 + 2 * i + 1]); w2[i] = pk2(o2[2 * i], o2[2 * i + 1]); w3[i] = pk2(o2[8 + 2 * i], o2[8 + 2 * i + 1]); }
      *(LAS u32x4*)(Qs + t * RS + 16 * c) = w0; *(LAS u32x4*)(Qs + t * RS + 16 * c + 8) = w1; *(LAS u32x4*)(Qs + t * RS + 64 + 16 * c) = w2; *(LAS u32x4*)(Qs + t * RS + 64 + 16 * c + 8) = w3;
      rot_apply(rk, rc, 1.0f, o1, o2);
#pragma unroll
      for (int i = 0; i < 4; ++i) { w0[i] = pk2(o1[2 * i], o1[2 * i + 1]); w1[i] = pk2(o1[8 + 2 * i], o1[8 + 2 * i + 1]); w2[i] = pk2(o2[2 * i], o2[2 * i + 1]); w3[i] = pk2(o2[8 + 2 * i], o2[8 + 2 * i + 1]); }
      *(LAS u32x4*)(Ks + t * RS + 16 * c) = w0; *(LAS u32x4*)(Ks + t * RS + 16 * c + 8) = w1; *(LAS u32x4*)(Ks + t * RS + 64 + 16 * c) = w2; *(LAS u32x4*)(Ks + t * RS + 64 + 16 * c + 8) = w3; }
    __syncthreads();
    const int w = __builtin_amdgcn_readfirstlane(tid >> 6), l = tid & 63, fr = l & 15, fq = l >> 4;
    bf16x8 qf[4];
#pragma unroll
    for (int s = 0; s < 4; ++s) qf[s] = *(const LAS bf16x8*)(Qs + (16 * w + fr) * RS + 32 * s + 8 * fq);
    f32x4 sc[8];
#pragma unroll
    for (int kt = 0; kt < 8; ++kt) { sc[kt] = (f32x4){0.f, 0.f, 0.f, 0.f};
        if (kt <= w) {
#pragma unroll
            for (int s = 0; s < 4; ++s) { const bf16x8 a = *(const LAS bf16x8*)(Ks + (16 * kt + fr) * RS + 32 * s + 8 * fq); sc[kt] = __builtin_amdgcn_mfma_f32_16x16x32_bf16(a, qf[s], sc[kt], 0, 0, 0); } } }
    const int q = 16 * w + fr;
    bf16x8 pf[4];
#pragma unroll
    for (int s2 = 0; s2 < 4; ++s2) { float v[8];
#pragma unroll
        for (int hh = 0; hh < 2; ++hh)
#pragma unroll
            for (int r = 0; r < 4; ++r) { const int kt = 2 * s2 + hh, d = q - (16 * kt + 4 * fq + r); v[4 * hh + r] = (d >= 0) ? sc[kt][r] * ex2(log2g * (float)d) : 0.f; }
        u32x4 pw; pw.x = pk2(v[0], v[1]); pw.y = pk2(v[2], v[3]); pw.z = pk2(v[4], v[5]); pw.w = pk2(v[6], v[7]); pf[s2] = __builtin_bit_cast(bf16x8, pw); }
    f32x4 accA[16];
#pragma unroll
    for (int mt = 0; mt < 16; ++mt) accA[mt] = (f32x4){0.f, 0.f, 0.f, 0.f};
#pragma unroll
    for (int s2 = 0; s2 < 4; ++s2) { if (s2 <= (w >> 1)) {
#pragma unroll
        for (int mt = 0; mt < 16; ++mt) { const bf16x8 a = *(const LAS bf16x8*)(Vt + (16 * mt + fr) * RS + 32 * s2 + 8 * fq); accA[mt] = __builtin_amdgcn_mfma_f32_16x16x32_bf16(a, pf[s2], accA[mt], 0, 0, 0); } } }
    __syncthreads();
#pragma unroll
    for (int it = 0; it < 8; ++it) { const int idx = tid + it * NT, dv = idx >> 4, ch = idx & 15; *(LAS u32x4*)(Vt + dv * RS + 8 * ch) = stp[it]; }
    const int qg = 16 * w + fr;
    const bf16* gp = proj + (size_t)(rowbase + qg) * DIN + C_G + h * 256 + 4 * fq;
    u32x2 gpre[16];
#pragma unroll
    for (int mt = 0; mt < 16; ++mt) gpre[mt] = *(const u32x2*)(gp + 16 * mt);
    __syncthreads();
    f32x4 accB[16];
#pragma unroll
    for (int mt = 0; mt < 16; ++mt) accB[mt] = (f32x4){0.f, 0.f, 0.f, 0.f};
#pragma unroll
    for (int s = 0; s < 4; ++s)
#pragma unroll
        for (int mt = 0; mt < 16; ++mt) { const bf16x8 a = *(const LAS bf16x8*)(Vt + (16 * mt + fr) * RS + 32 * s + 8 * fq); accB[mt] = __builtin_amdgcn_mfma_f32_16x16x32_bf16(a, qf[s], accB[mt], 0, 0, 0); }
    const float dq = ex2(log2g * (float)(q + 1));
    float sum = 0.f;
#pragma unroll
    for (int mt = 0; mt < 16; ++mt) { accA[mt] = accA[mt] + accB[mt] * dq; sum += (accA[mt][0] + accA[mt][1]) + (accA[mt][2] + accA[mt][3]); }
    sum += __shfl_xor(sum, 16); sum += __shfl_xor(sum, 32);
    const float mu = sum * (1.0f / 256.0f); float var = 0.f;
#pragma unroll
    for (int mt = 0; mt < 16; ++mt) { accA[mt] = accA[mt] - mu; var += (accA[mt][0] * accA[mt][0] + accA[mt][1] * accA[mt][1]) + (accA[mt][2] * accA[mt][2] + accA[mt][3] * accA[mt][3]); }
    var += __shfl_xor(var, 16); var += __shfl_xor(var, 32);
    const float rstd = rsqrtf(var * (1.0f / 256.0f) + pg8::NORM_EPS);
    const size_t R = (size_t)(rowbase + q);
    bf16* op = AB + R * 2048 + 1024 + h * 256 + 4 * fq;
#pragma unroll
    for (int mt = 0; mt < 16; ++mt) { const u32x2 g2 = gpre[mt]; const float g0 = bflo(g2.x), g1 = bfhi(g2.x), g2f = bflo(g2.y), g3 = bfhi(g2.y);
        const float y0 = accA[mt][0] * rstd * g0 * __builtin_amdgcn_rcpf(1.f + __expf(-g0)), y1 = accA[mt][1] * rstd * g1 * __builtin_amdgcn_rcpf(1.f + __expf(-g1)), y2 = accA[mt][2] * rstd * g2f * __builtin_amdgcn_rcpf(1.f + __expf(-g2f)), y3 = accA[mt][3] * rstd * g3 * __builtin_amdgcn_rcpf(1.f + __expf(-g3));
        u32x2 o; o.x = pk2(y0, y1); o.y = pk2(y2, y3); *(u32x2*)(op + 16 * mt) = o; }
    __syncthreads();
}
__device__ __forceinline__ void conv_item(const bf16* proj, bf16* AB, const float* cw, int ci, int tid) {
    asm volatile("" : "+v"(tid));
    const int c0 = (tid & 127) * 8, t0 = ci * 64 + (tid >> 7) * 16;
    float w0[8], w1[8], w2[8], z1[8], z2[8];
#pragma unroll
    for (int e = 0; e < 8; ++e) { w0[e] = cw[c0 + e]; w1[e] = cw[1024 + c0 + e]; w2[e] = cw[2048 + c0 + e]; z1[e] = 0.f; z2[e] = 0.f; }
    if ((t0 & (SEQ - 1)) != 0) {
        const bf16* p2 = proj + (size_t)(t0 - 2) * DIN + C_CC + c0;
        const u32x4 a2 = *(const u32x4*)p2, a1 = *(const u32x4*)(p2 + DIN);
#pragma unroll
        for (int i = 0; i < 4; ++i) { z2[2 * i] = bflo(a2[i]); z2[2 * i + 1] = bfhi(a2[i]); z1[2 * i] = bflo(a1[i]); z1[2 * i + 1] = bfhi(a1[i]); }
    }
#pragma unroll 1
    for (int tb = 0; tb < 16; tb += 8) { u32x4 vb[8], vz[8];
#pragma unroll
        for (int tt = 0; tt < 8; ++tt) { const bf16* p = proj + (size_t)(t0 + tb + tt) * DIN + c0; vb[tt] = *(const u32x4*)(p + C_CB); vz[tt] = *(const u32x4*)(p + C_CC); }
#pragma unroll
        for (int tt = 0; tt < 8; ++tt) { float z[8], o[8];
#pragma unroll
            for (int i = 0; i < 4; ++i) { z[2 * i] = bflo(vz[tt][i]); z[2 * i + 1] = bfhi(vz[tt][i]); }
#pragma unroll
            for (int i = 0; i < 4; ++i) { o[2 * i] = bflo(vb[tt][i]) * (w0[2 * i] * z2[2 * i] + w1[2 * i] * z1[2 * i] + w2[2 * i] * z[2 * i]);
                o[2 * i + 1] = bfhi(vb[tt][i]) * (w0[2 * i + 1] * z2[2 * i + 1] + w1[2 * i + 1] * z1[2 * i + 1] + w2[2 * i + 1] * z[2 * i + 1]); }
            u32x4 ow; ow.x = pk2(o[0], o[1]); ow.y = pk2(o[2], o[3]); ow.z = pk2(o[4], o[5]); ow.w = pk2(o[6], o[7]);
            *(u32x4*)(AB + (size_t)(t0 + tb + tt) * 2048 + c0) = ow;
#pragma unroll
            for (int e = 0; e < 8; ++e) { z2[e] = z1[e]; z1[e] = z[e]; } } }
}

#define XB_TMO      128
#define XB_XCNT(j)  (256  + 64 * (j))
#define XB_XSUB(j)  (1280 + 64 * (j))
#define XB_XGEN(j)  (2304 + 64 * (j))
#define XB_TOP      3328
#define XB_TOPGEN   3392
#define XCD_BAR_WORDS 3456
#define XB_SPIN_CAP (1u << 18)

__device__ __forceinline__ unsigned xb_ld(unsigned* p)              { return __hip_atomic_load(p, __ATOMIC_RELAXED, __HIP_MEMORY_SCOPE_AGENT); }
__device__ __forceinline__ unsigned xb_add(unsigned* p, unsigned v) { return __hip_atomic_fetch_add(p, v, __ATOMIC_RELAXED, __HIP_MEMORY_SCOPE_AGENT); }
__device__ __forceinline__ unsigned xb_xcc_id() { return (unsigned)__builtin_amdgcn_s_getreg((3 << 11) | 20) & 0xFu; }
#define XB_SPIN(cond, bar) do { unsigned _sp = 0; while (cond) { __builtin_amdgcn_s_sleep(1); \
    if ((++_sp & 255u) == 0u) { if (xb_ld(&(bar)[XB_TMO])) break; if (_sp > XB_SPIN_CAP) { atomicAdd(&(bar)[XB_TMO], 1u); break; } } } } while (0)

struct XcdBarrier {
    unsigned* bar; unsigned x;
    volatile LAS unsigned* st;
};

__device__ __forceinline__ XcdBarrier xcd_barrier_post(unsigned* bar, volatile LAS unsigned* st) {
    XcdBarrier b; b.bar = bar; b.x = xb_xcc_id(); b.st = st;
    if (threadIdx.x == 0) (void)xb_add(&bar[XB_XCNT(b.x)], 1u);
    return b;
}
__device__ __forceinline__ void xcd_barrier_complete(unsigned* bar, unsigned x, unsigned& nloc, unsigned& nx) {
    const unsigned G = gridDim.x * gridDim.y * gridDim.z;
    unsigned sum, cnt, mine, sp = 0u;
    for (;;) {
        sum = 0u; cnt = 0u; mine = 0u;
#pragma unroll
        for (unsigned j = 0; j < 16; ++j) { const unsigned c = xb_ld(&bar[XB_XCNT(j)]); sum += c; cnt += (c > 0u) ? 1u : 0u; mine = (j == x) ? c : mine; }
        if (sum == G) break;
        __builtin_amdgcn_s_sleep(1);
        if ((++sp & 255u) == 0u) { if (xb_ld(&bar[XB_TMO])) break; if (sp > XB_SPIN_CAP) { atomicAdd(&bar[XB_TMO], 1u); break; } }
    }
    nloc = mine > 0u ? mine : 1u; nx = cnt > 0u ? cnt : 1u;
}

__device__ __forceinline__ void xcd_barrier(const XcdBarrier& b) {
    asm volatile("s_waitcnt vmcnt(0)" ::: "memory");
    __syncthreads();
    if (threadIdx.x == 0) {
        unsigned* bar = b.bar;
        __builtin_amdgcn_s_waitcnt(0);
        unsigned nloc = b.st[0], nx = b.st[1];
        if (nloc == 0u) { xcd_barrier_complete(bar, b.x, nloc, nx); b.st[0] = nloc; b.st[1] = nx; }
        const unsigned old = xb_add(&bar[XB_XSUB(b.x)], 1u);
        const unsigned gen = old / nloc;
        if (old + 1u == (gen + 1u) * nloc) {
            __builtin_amdgcn_fence(__ATOMIC_RELEASE, "agent");
            asm volatile("s_waitcnt vmcnt(0)" ::: "memory");
            const unsigned og = xb_add(&bar[XB_TOP], 1u);
            const unsigned tg = og / nx;
            if (og + 1u == (tg + 1u) * nx) xb_add(&bar[XB_TOPGEN], 1u);
            else XB_SPIN(xb_ld(&bar[XB_TOPGEN]) == tg, bar);
            __builtin_amdgcn_fence(__ATOMIC_ACQUIRE, "agent");
            xb_add(&bar[XB_XGEN(b.x)], 1u);
            asm volatile("s_waitcnt vmcnt(0)" ::: "memory");
        } else {
            XB_SPIN(xb_ld(&bar[XB_XGEN(b.x)]) == gen, bar);
            __builtin_amdgcn_fence(__ATOMIC_ACQUIRE, "agent");
            asm volatile("s_waitcnt vmcnt(0)" ::: "memory");
        }
    }
    __syncthreads();
}


struct Args { const float* in[13]; float* out; unsigned char* ws; };
#define PH_P0 0
#define PH_PX 1
#define PH_P1 2
#define PH_P2A 3
#define PH_P2B 4
#define PH_P2C 5
#define PH_P3 6
#define PH_P4 7
#define PH_P5 8
#define PH_P6 9
#define PH_PF 10
#ifndef REPMASK
#define REPMASK 0
#endif
#ifdef XSYNC
#define GSYNC() do { xcd_barrier(xbar); xcd_barrier(xbar); } while (0)
#else
#define GSYNC() xcd_barrier(xbar)
#endif
#define REPS(id) (1 + (((REPMASK) >> (id)) & 1))
#ifdef PROBE_A
#define STAMP(id) do { const unsigned long long now_ = __builtin_amdgcn_s_memrealtime(); if (((PROBE_A) >> (id)) & 1) ta_ += now_ - tprev_; if (((PROBE_B) >> (id)) & 1) tb_ += now_ - tprev_; tprev_ = now_; } while (0)
#else
#define STAMP(id) do { } while (0)
#endif
__global__ void __launch_bounds__(NT, 2) hybrid_fwd(Args args) {
    extern __shared__ __attribute__((aligned(16))) unsigned char lds_raw[];
    LAS unsigned char* lds = (LAS unsigned char*)lds_raw;
    cg::grid_group grid = cg::this_grid();
    const int tid = threadIdx.x, lane = tid & 63, wave = __builtin_amdgcn_readfirstlane(tid >> 6);
    const int G = gridDim.x, bx = blockIdx.x;
    const int gw = bx * NWAVES + wave, NGW = G * NWAVES;
    unsigned char* ws = args.ws;
    volatile LAS unsigned* stw = (volatile LAS unsigned*)(lds + LDS_BYTES - 64);
    if (tid < 16) stw[tid] = 0u;
    __syncthreads();
    const XcdBarrier xbar = xcd_barrier_post((unsigned*)(ws + WS_BAR), stw);
    const float* x_in = args.in[0]; const int* positions = (const int*)args.in[1];
    const float *norm_mix = args.in[2], *w_in = args.in[3], *conv_w = args.in[4], *w_conv_out = args.in[5], *ret_norm = args.in[6], *w_ret_out = args.in[7], *w_o = args.in[8],
                *norm_mlp = args.in[9], *w_up = args.in[10], *w_down = args.in[11], *norm_final = args.in[12];
    float* ssall = (float*)(ws + WS_SS);
    bf16* XB = (bf16*)(ws + WS_XB); bf16* AB = (bf16*)(ws + WS_AB); bf16* KV = (bf16*)(ws + WS_KV); bf16* MG = (bf16*)(ws + WS_MG); bf16* ST = (bf16*)(ws + WS_ST);
    bf16* PROJ = (bf16*)(ws + WS_PROJ); bf16* U = (bf16*)(ws + WS_U); float* ROT = (float*)(ws + WS_ROT);

#ifdef PROBE_A
    unsigned long long tprev_ = __builtin_amdgcn_s_memrealtime(), ta_ = 0, tb_ = 0;
#endif
    {
        LAS float* scr = (LAS float*)(lds + wave * 16640);
        constexpr int I_IN = 16 * 128, I_SQ = 16 * 16, I_UP = 16 * 64, I_DN = 64 * 16, I_LAYER = I_IN + 3 * I_SQ + I_UP + I_DN;
        for (int rep_ = 0; rep_ < REPS(PH_P0); ++rep_)
        for (int it = gw; it < DEPTH * I_LAYER; it += NGW) {
            const int L = it / I_LAYER; int r = it % I_LAYER; bf16* wl = (bf16*)(ws + WS_W + (size_t)L * W_LAYER);
            if (r < I_IN) { transpose_item(w_in + (size_t)L * D * DIN, D, DIN, (bf16*)((char*)wl + W_IN), D, 0, norm_mix + L * D, scr, r, lane, true); continue; } r -= I_IN;
            if (r < I_SQ) { transpose_item(w_conv_out + (size_t)L * D * D, D, D, (bf16*)((char*)wl + W_CR), 2048, 0, nullptr, scr, r, lane); continue; } r -= I_SQ;
            if (r < I_SQ) { transpose_item(w_ret_out + (size_t)L * D * D, D, D, (bf16*)((char*)wl + W_CR), 2048, 1024, ret_norm + L * D, scr, r, lane); continue; } r -= I_SQ;
            if (r < I_SQ) { transpose_item(w_o + (size_t)L * D * D, D, D, (bf16*)((char*)wl + W_O), D, 0, nullptr, scr, r, lane); continue; } r -= I_SQ;
            if (r < I_UP) { transpose_item(w_up + (size_t)L * D * FF, D, FF, (bf16*)((char*)wl + W_UP), D, 0, norm_mlp + L * D, scr, r, lane); continue; } r -= I_UP;
            transpose_item(w_down + (size_t)L * FF * D, FF, D, (bf16*)((char*)wl + W_DN), FF, 0, nullptr, scr, r, lane);
        }
        for (int i = bx * NT + tid; i < 2 * 4 * MH; i += G * NT) { const int hf = i / (4 * MH), r = i % (4 * MH); ssall[(size_t)hf * 5 * MH + MH + r] = 0.f; }
    }

    for (int hf = 0; hf < 2; ++hf) {
        float* ss = ssall + (size_t)hf * 5 * MH;
        const float* xh = x_in + (size_t)hf * MH * D; float* outh = args.out + (size_t)hf * MH * D;
        int lnx = lane; asm volatile("" : "+v"(lnx));
        for (int rep_ = 0; rep_ < REPS(PH_PX); ++rep_)
        for (int row0 = gw; row0 < MH; row0 += 4 * NGW) {
            f32x4 v[4][4];
#pragma unroll
            for (int k = 0; k < 4; ++k) { const int row = min(row0 + k * NGW, MH - 1); const f32x4* xr = (const f32x4*)(xh + (size_t)row * D) + lnx;
#pragma unroll
                for (int j = 0; j < 4; ++j) v[k][j] = xr[64 * j]; }
#pragma unroll
            for (int k = 0; k < 4; ++k) { const int row = row0 + k * NGW; if (row < MH) { float s = 0.f;
#pragma unroll
                for (int j = 0; j < 4; ++j) s += (v[k][j][0] * v[k][j][0] + v[k][j][1] * v[k][j][1]) + (v[k][j][2] * v[k][j][2] + v[k][j][3] * v[k][j][3]);
                s = wave_sum(s); if (lnx == 0) ss[row] = s;
                u32x2* o8 = (u32x2*)(XB + (size_t)row * D) + lnx;
#pragma unroll
                for (int j = 0; j < 4; ++j) { u32x2 o; o.x = pk2(v[k][j][0], v[k][j][1]); o.y = pk2(v[k][j][2], v[k][j][3]); o8[64 * j] = o; } } }
        }
        { int trt = tid; asm volatile("" : "+v"(trt));
          for (int idx = bx * NT + trt; idx < MH * 64; idx += G * NT) { const int row = idx >> 6, j = idx & 63;
              const float ang = (float)positions[(size_t)hf * MH + row] * ex2(-(float)j * 0.20762050593046014f);
              double rev = (double)ang * 0.15915494309189535; rev -= __builtin_rint(rev); const float fr = (float)rev;
              float2 o; o.x = __builtin_amdgcn_cosf(fr); o.y = __builtin_amdgcn_sinf(fr); *(float2*)(ROT + (size_t)idx * 2) = o; } }
        if (G == 0x7fffffff) grid.sync();
        GSYNC();
        STAMP(PH_PX);
        for (int L = 0; L < DEPTH; ++L) {
            const unsigned char* wl = ws + WS_W + (size_t)L * W_LAYER;
            for (int rep_ = 0; rep_ < REPS(PH_P1); ++rep_) {
#ifdef P1_STAGGER
            { const unsigned long long t0_ = __builtin_amdgcn_s_memrealtime(), dl_ = (unsigned long long)(((bx >> 3) & 3) * P1_STAGGER);
              while (__builtin_amdgcn_s_memrealtime() - t0_ < dl_) __builtin_amdgcn_s_sleep(8); }
#endif
            { pg8::Gemm g{XB, (const bf16*)(wl + W_IN), MH, DIN, D}; pg8::StaticOrder S; S.init(MH, DIN, G, bx);
              pg8::Unit u0{0, 0}; (void)S.next(0, u0);
              LAS float* rtab = (LAS float*)(lds + 131072); { int tr_ = tid; asm volatile("" : "+v"(tr_)); if (tr_ < 256) rtab[tr_] = rsqrtf((ss + (2 * L) * MH)[u0.pm * 256 + tr_] * (1.0f / 1024.0f) + pg8::NORM_EPS); } __syncthreads();
              pg8::EpiScaleBf16<0, true, true> E{PROJ, DIN, ss + (2 * L) * MH, rtab, u0.pm};
#ifdef PROBE_NOSTORE
              if (rep_ == 1) { pg8::EpiScaleBf16<0, false> E2{PROJ, DIN, ss + (2 * L) * MH, rtab, u0.pm}; pg8::gemm_phase<pg8::EpiScaleBf16<0, false>, pg8::StaticOrder, true, true>(lds, g, S, E2); } else
#endif
              pg8::gemm_phase<pg8::EpiScaleBf16<0, true, true>, pg8::StaticOrder, true, true>(lds, g, S, E); }
            }
            GSYNC(); STAMP(PH_P1);
            for (int rep_ = 0; rep_ < REPS(PH_P2A); ++rep_) {
            for (int it = bx; it < HB * NH * NCH; it += G) { const int i = it & 31, h = (it >> 5) & 3, bl = it >> 7;
                const float log2g = __log2f(1.0f - ex2(-5.0f - (float)h));
                kv_item(lds, PROJ, ROT, KV + (size_t)it * 32768, bl * SEQ + i * CH, h, log2g, tid); }
            }
            GSYNC(); STAMP(PH_P2A);
            for (int rep_ = 0; rep_ < REPS(PH_P2B); ++rep_) {
            int tsc = tid; asm volatile("" : "+v"(tsc));
            for (int gidx = bx * NT + tsc; gidx < 16 * 8192; gidx += G * NT) { const int pair = gidx >> 13, e = (gidx & 8191) * 4, h = pair & 3;
                const float gC = ex2(128.0f * __log2f(1.0f - ex2(-5.0f - (float)h)));
                f32x4 s = (f32x4){0.f, 0.f, 0.f, 0.f};
                const size_t idx0 = (size_t)(pair * 32) * 32768 + e;
                { constexpr int i0 = 0; u32x2 kw[NCH];
#pragma unroll
                    for (int j = 0; j < NCH; ++j) kw[j] = *(const u32x2*)(KV + idx0 + (size_t)(i0 + j) * 32768);
#pragma unroll
                    for (int j = 0; j < NCH; ++j) { u32x2 o; o.x = pk2(s[0], s[1]); o.y = pk2(s[2], s[3]); *(u32x2*)(ST + idx0 + (size_t)(i0 + j) * 32768) = o;
                        const f32x4 kv = (f32x4){bflo(kw[j].x), bfhi(kw[j].x), bflo(kw[j].y), bfhi(kw[j].y)}; s = s * gC + kv; } } }
            }
            GSYNC(); STAMP(PH_P2B);
            for (int rep_ = 0; rep_ < REPS(PH_P2C); ++rep_) {
            if (bx & 8) for (int ci = bx; ci < MH / 64; ci += G) conv_item(PROJ, AB, conv_w + (size_t)L * 3 * D, ci, tid);
            for (int it = bx; it < HB * NH * NCH; it += G) { const int i = it & 31, h = (it >> 5) & 3, bl = it >> 7;
                const float log2g = __log2f(1.0f - ex2(-5.0f - (float)h));
                ret_item(lds, PROJ, ROT, ST + (size_t)it * 32768, AB, bl * SEQ + i * CH, h, log2g, tid); }
            if (!(bx & 8)) for (int ci = bx; ci < MH / 64; ci += G) conv_item(PROJ, AB, conv_w + (size_t)L * 3 * D, ci, tid);
            }
            GSYNC(); STAMP(PH_P2C);
            for (int rep_ = 0; rep_ < REPS(PH_P3); ++rep_) {
            { pg8::Gemm g{AB, (const bf16*)(wl + W_CR), MH, D, 2048}; pg8::StaticOrder S; S.init(MH, D, G, bx);
              pg8::EpiMerge E{PROJ, MG};
              pg8::gemm_phase<pg8::EpiMerge, pg8::StaticOrder, true, true>(lds, g, S, E); }
            }
            GSYNC(); STAMP(PH_P3);
            { pg8::Gemm g{MG, (const bf16*)(wl + W_O), MH, D, D}; pg8::StaticOrder S; S.init(MH, D, G, bx);
              pg8::EpiResidual E{L == 0 ? xh : (const float*)outh, outh, XB, ss + (2 * L + 1) * MH};
              pg8::gemm_phase<pg8::EpiResidual, pg8::StaticOrder, true, true>(lds, g, S, E); }
            GSYNC(); STAMP(PH_P4);
            for (int rep_ = 0; rep_ < REPS(PH_P5); ++rep_) {
            { pg8::Gemm g{XB, (const bf16*)(wl + W_UP), MH, FF, D}; pg8::StaticOrder S; S.init(MH, FF, G, bx);
              pg8::Unit u0{0, 0}; (void)S.next(0, u0);
              LAS float* rtab = (LAS float*)(lds + 131072); { int tr_ = tid; asm volatile("" : "+v"(tr_)); if (tr_ < 256) rtab[tr_] = rsqrtf((ss + (2 * L + 1) * MH)[u0.pm * 256 + tr_] * (1.0f / 1024.0f) + pg8::NORM_EPS); } __syncthreads();
              pg8::EpiScaleBf16<1> E{U, FF, ss + (2 * L + 1) * MH, rtab, u0.pm};
              pg8::gemm_phase<pg8::EpiScaleBf16<1>, pg8::StaticOrder, true, true>(lds, g, S, E); }
            }
            GSYNC(); STAMP(PH_P5);
            { pg8::Gemm g{U, (const bf16*)(wl + W_DN), MH, D, FF}; pg8::StaticOrder S; S.init(MH, D, G, bx);
              pg8::EpiResidual E{outh, outh, L + 1 < DEPTH ? XB : (bf16*)nullptr, ss + (2 * L + 2) * MH};
              pg8::gemm_phase<pg8::EpiResidual, pg8::StaticOrder, true, true>(lds, g, S, E); }
            GSYNC(); STAMP(PH_P6);
        }
        int lnf = lane; asm volatile("" : "+v"(lnf));
        { const f32x4* gr = (const f32x4*)norm_final + lnf; f32x4 gv[4];
#pragma unroll
          for (int j = 0; j < 4; ++j) gv[j] = gr[64 * j];
          for (int row0 = gw; row0 < MH; row0 += 4 * NGW) {
            f32x4 v[4][4]; float rs[4];
#pragma unroll
            for (int k = 0; k < 4; ++k) { const int row = min(row0 + k * NGW, MH - 1); const f32x4* xr = (const f32x4*)(outh + (size_t)row * D) + lnf; rs[k] = ss[4 * MH + row];
#pragma unroll
                for (int j = 0; j < 4; ++j) v[k][j] = xr[64 * j]; }
#pragma unroll
            for (int k = 0; k < 4; ++k) { const int row = row0 + k * NGW; if (row < MH) { f32x4* xr = (f32x4*)(outh + (size_t)row * D) + lnf;
                const float r = rsqrtf(rs[k] * (1.0f / 1024.0f) + pg8::NORM_EPS);
#pragma unroll
                for (int j = 0; j < 4; ++j) { f32x4 o = v[k][j] * r * gv[j];
#ifdef PROBE_A
                    if (hf == 1 && (row & 15) == 0) o = o + (float)tb_ * 0.01f;
#endif
                    xr[64 * j] = o; } } }
          } }
#ifdef PROBE_A
        if (hf == 1) { __syncthreads(); if (bx == 0 && tid == 0) args.out[0] = (float)ta_; }
#endif
    }
}

extern "C" void kernel_launch(void* const* d_in, const int* in_sizes, int n_in, void* d_out, int out_size, void* d_ws, size_t ws_size, hipStream_t stream) {
    static int grid = 0;
    if (grid == 0) {
        if (n_in != 13 || out_size != NB * SEQ * D || ws_size < WS_END) { fprintf(stderr, "kernel_launch: unexpected shapes (n_in %d, out %d, ws %zu < %zu)\n", n_in, out_size, ws_size, (size_t)WS_END); grid = -1; return; }
        int dev = 0, cus = 0, per_cu = 0;
        (void)hipGetDevice(&dev); (void)hipDeviceGetAttribute(&cus, hipDeviceAttributeMultiprocessorCount, dev);
        if (hipFuncSetAttribute((const void*)hybrid_fwd, hipFuncAttributeMaxDynamicSharedMemorySize, LDS_BYTES) != hipSuccess) { fprintf(stderr, "kernel_launch: hipFuncSetAttribute failed\n"); grid = -1; return; }
        if (hipOccupancyMaxActiveBlocksPerMultiprocessor(&per_cu, (const void*)hybrid_fwd, NT, LDS_BYTES) != hipSuccess || per_cu < 1) { fprintf(stderr, "kernel_launch: occupancy query says %d\n", per_cu); per_cu = 1; }
        (void)hipGetLastError();
        grid = cus * per_cu;
    }
    if (grid < 0) return;
    if (hipMemsetAsync((char*)d_ws + WS_BAR, 0, BAR_BYTES, stream) != hipSuccess) { fprintf(stderr, "kernel_launch: memset failed\n"); return; }
    Args a{};
    for (int i = 0; i < 13; ++i) a.in[i] = (const float*)d_in[i];
    a.out = (float*)d_out; a.ws = (unsigned char*)d_ws;
    void* kargs[] = {&a};
    hipError_t e = hipLaunchCooperativeKernel((const void*)hybrid_fwd, dim3(grid), dim3(NT), kargs, LDS_BYTES, stream);
    if (e != hipSuccess) fprintf(stderr, "kernel_launch: cooperative launch failed: %s (grid %d)\n", hipGetErrorString(e), grid);
}
```

```cpp
#include <hip/hip_runtime.h>
#include <hip/hip_cooperative_groups.h>
#include <cstdio>
#include <cstdint>
namespace cg = cooperative_groups;
namespace pg8 {
#define PG8_LAS __attribute__((address_space(3)))
typedef unsigned short bf16_t;
typedef short bf16x8 __attribute__((ext_vector_type(8)));
typedef float f32x4 __attribute__((ext_vector_type(4)));
typedef unsigned u32x4 __attribute__((ext_vector_type(4)));
constexpr int BM = 256, BK = 64, HALF = 128, HTB = HALF * BK * 2  , STAGE_BYTES = 8 * HTB, NXCD = 8, WGM = 8;

__host__ __device__ __forceinline__ int lds_byte(int r, int c) { const int st = (r >> 4) * 2 + (c >> 5), rr = r & 15, cc = c & 31, ob = rr * 64 + cc * 2; return st * 1024 + (ob ^ (((ob >> 9) & 1) << 5)); }
__host__ __device__ __forceinline__ void stage_rc(int b, int& R, int& C) { const int st = b / 1024, sb = b % 1024, swz = sb ^ (((sb >> 9) & 1) << 5); R = (st >> 1) * 16 + swz / 64; C = (st & 1) * 32 + (swz % 64) / 2; }
__host__ __device__ __forceinline__ int perm32(int rho) { const int n = rho >> 4, i = rho & 15; return 8 * (i >> 2) + 4 * n + (i & 3); }

struct Unit { int pm, pn; };
struct Gemm { const bf16_t* A; const bf16_t* Bt; int M, N, K; };

struct StaticOrder {
    int nM, nN, nwg, G, c;
    __host__ __device__ void init(int M, int N, int G_, int c_) { nM = M / BM; nN = N / BM; nwg = nM * nN; G = G_; c = c_; }
    __host__ __device__ bool next(int i, Unit& u) const {
        const long L = (long)i * G + c; if (L >= nwg) return false;
        int wgid = (int)L; { const int q = nwg / NXCD, r = nwg % NXCD, xcd = wgid % NXCD, off = wgid / NXCD; wgid = (xcd < r ? xcd * (q + 1) : r * (q + 1) + (xcd - r) * q) + off; }
        const int nig = WGM * nN, gid = wgid / nig, fm = gid * WGM, gsz = (nM - fm) < WGM ? (nM - fm) : WGM;
        u.pm = fm + ((wgid % nig) % gsz); u.pn = (wgid % nig) / gsz; return true;
    }
    __device__ __forceinline__ void a_ready(const Unit&) const {}
    __device__ __forceinline__ void done(const Unit&) const {}
};

__device__ __forceinline__ unsigned cvt_pk_bf16(float lo, float hi) { unsigned r; asm volatile("v_cvt_pk_bf16_f32 %0, %1, %2" : "=v"(r) : "v"(lo), "v"(hi)); return r; }
typedef float f32x2 __attribute__((ext_vector_type(2)));

typedef __bf16 bf16x2n __attribute__((ext_vector_type(2)));
__device__ __forceinline__ unsigned cvt_pk_bf16c(float lo, float hi) { const f32x2 v = {lo, hi}; return __builtin_bit_cast(unsigned, __builtin_convertvector(v, bf16x2n)); }

constexpr float NORM_EPS = 1e-6f;
template <int ACT, bool STORE = true, bool ZF = false> struct EpiScaleBf16 {
    static constexpr bool PERM = true, AFTER_DRAIN = false, MIDHOOK = false, HASINIT = false; static constexpr int NSTORES = STORE ? 16 : 0;
    static __device__ __forceinline__ int nstores(const Unit& u) { return STORE ? ((ZF && u.pn >= 4 && u.pn < 12) ? 8 : 16) : 0; }
    bf16_t* O; int ldc; const float* ss; const PG8_LAS float* rtab; int pm0;
    __device__ __forceinline__ void operator()(const f32x4 (&acc)[2][2][4][2], const Unit& u, int wr, int wc, int fr, int fq) const {
        int row0 = u.pm * BM + wr * 64 + fr; asm volatile("" : "+v"(row0)); const int col0 = u.pn * BM + wc * 32 + 8 * fq;
        float rr[8];
        if (u.pm == pm0) {
#pragma unroll
            for (int i = 0; i < 8; ++i) rr[i] = rtab[row0 - u.pm * BM + (i >> 2) * HALF + (i & 3) * 16];
        } else {
#pragma unroll
            for (int i = 0; i < 8; ++i) rr[i] = rsqrtf(ss[row0 + (i >> 2) * HALF + (i & 3) * 16] * (1.0f / 1024.0f) + NORM_EPS);
        }
        if (ZF && u.pn >= 4 && u.pn < 12) {
            const int zc0 = 1024 + (u.pn - 4) * HALF + wc * 32 + 8 * fq;
#pragma unroll
            for (int ai = 0; ai < 2; ++ai)
#pragma unroll
                for (int m = 0; m < 4; ++m) { const int row = row0 + ai * HALF + m * 16; const float r = rr[ai * 4 + m], r2 = r * r;
                    const f32x4 v0 = acc[ai][0][m][0] * acc[ai][1][m][0] * r2, v1 = acc[ai][0][m][1] * acc[ai][1][m][1] * r2;
                    u32x4 w; w.x = cvt_pk_bf16(v0[0], v0[1]); w.y = cvt_pk_bf16(v0[2], v0[3]); w.z = cvt_pk_bf16(v1[0], v1[1]); w.w = cvt_pk_bf16(v1[2], v1[3]);
                    *(u32x4*)(O + (size_t)row * ldc + zc0) = w; }
            return;
        }
#pragma unroll
        for (int ai = 0; ai < 2; ++ai)
#pragma unroll
            for (int m = 0; m < 4; ++m) { const int row = row0 + ai * HALF + m * 16; const float r = rr[ai * 4 + m];
                bf16_t* rowp = O + (size_t)row * ldc + col0;
#pragma unroll
                for (int bj = 0; bj < 2; ++bj) { f32x4 v0 = acc[ai][bj][m][0] * r, v1 = acc[ai][bj][m][1] * r;
                    if (ACT == 1) {
#pragma unroll
                        for (int j = 0; j < 4; ++j) { const float a = fmaxf(v0[j], 0.f), b = fmaxf(v1[j], 0.f); v0[j] = a * a; v1[j] = b * b; } }
                    u32x4 w; w.x = cvt_pk_bf16(v0[0], v0[1]); w.y = cvt_pk_bf16(v0[2], v0[3]); w.z = cvt_pk_bf16(v1[0], v1[1]); w.w = cvt_pk_bf16(v1[2], v1[3]);
                    if (STORE) *(u32x4*)(rowp + bj * HALF) = w; } }
    }
};
__device__ __forceinline__ float bf_lo(unsigned w) { return __uint_as_float(w << 16); }
__device__ __forceinline__ float bf_hi(unsigned w) { return __uint_as_float(w & 0xffff0000u); }
__device__ __forceinline__ float clamp30(float x) { return fminf(fmaxf(x, -30.f), 30.f); }
struct EpiMerge {
    static constexpr bool PERM = true, AFTER_DRAIN = false, MIDHOOK = true, HASINIT = false; static constexpr int NSTORES = 0;
    static __device__ __forceinline__ int nstores(const Unit&) { return 0; }
    const bf16_t* proj; bf16_t* O;
    __device__ __forceinline__ void mid(f32x4 (&acc)[2][2][4][2], const Unit& u, int wr, int wc, int fr, int fq) const {
        int row0 = u.pm * BM + wr * 64 + fr; asm volatile("" : "+v"(row0)); const int col0 = u.pn * BM + wc * 32 + 8 * fq;
#pragma unroll
        for (int ai = 0; ai < 2; ++ai) { u32x4 ga[4][2], gb[4][2];
#pragma unroll
            for (int m = 0; m < 4; ++m) { const bf16_t* rowp = proj + (size_t)(row0 + ai * HALF + m * 16) * 8192 + col0;
#pragma unroll
                for (int bj = 0; bj < 2; ++bj) { ga[m][bj] = *(const u32x4*)(rowp + 6144 + bj * HALF); gb[m][bj] = *(const u32x4*)(rowp + 7168 + bj * HALF); } }
#pragma unroll
            for (int m = 0; m < 4; ++m) {
#pragma unroll
                for (int bj = 0; bj < 2; ++bj) { const u32x4 a = ga[m][bj], b = gb[m][bj];
#pragma unroll
                    for (int j = 0; j < 4; ++j) { const float ea0 = __expf(-clamp30(bf_lo(a[j]))), ea1 = __expf(-clamp30(bf_hi(a[j]))), eb0 = __expf(-clamp30(bf_lo(b[j]))), eb1 = __expf(-clamp30(bf_hi(b[j])));
                        const float r0 = (1.f + eb0) * __builtin_amdgcn_rcpf(1.f + ea0), r1 = (1.f + eb1) * __builtin_amdgcn_rcpf(1.f + ea1);
                        acc[ai][bj][m][j >> 1][(j & 1) * 2] *= r0; acc[ai][bj][m][j >> 1][(j & 1) * 2 + 1] *= r1; } } }
            asm volatile("" ::: "memory"); }
    }
    __device__ __forceinline__ void operator()(const f32x4 (&acc)[2][2][4][2], const Unit& u, int wr, int wc, int fr, int fq) const {
        int row0 = u.pm * BM + wr * 64 + fr; asm volatile("" : "+v"(row0)); const int col0 = u.pn * BM + wc * 32 + 8 * fq;
        u32x4 gb[8][2];
#pragma unroll
        for (int i = 0; i < 8; ++i) { const bf16_t* rowp = proj + (size_t)(row0 + (i >> 2) * HALF + (i & 3) * 16) * 8192 + 7168 + col0; gb[i][0] = *(const u32x4*)rowp; gb[i][1] = *(const u32x4*)(rowp + HALF); }
#pragma unroll
        for (int ai = 0; ai < 2; ++ai)
#pragma unroll
            for (int m = 0; m < 4; ++m) { const size_t row = (size_t)(row0 + ai * HALF + m * 16);
#pragma unroll
                for (int bj = 0; bj < 2; ++bj) { const u32x4 b = gb[ai * 4 + m][bj]; float v[8];
#pragma unroll
                    for (int j = 0; j < 4; ++j) { const float s0 = __builtin_amdgcn_rcpf(1.f + __expf(-clamp30(bf_lo(b[j])))), s1 = __builtin_amdgcn_rcpf(1.f + __expf(-clamp30(bf_hi(b[j]))));
                        v[2 * j] = acc[ai][bj][m][j >> 1][(j & 1) * 2] * s0; v[2 * j + 1] = acc[ai][bj][m][j >> 1][(j & 1) * 2 + 1] * s1; }
                    u32x4 w; w.x = cvt_pk_bf16(v[0], v[1]); w.y = cvt_pk_bf16(v[2], v[3]); w.z = cvt_pk_bf16(v[4], v[5]); w.w = cvt_pk_bf16(v[6], v[7]);
                    *(u32x4*)(O + row * 1024 + col0 + bj * HALF) = w; } }
    }
};
struct EpiResidual {
    static constexpr bool PERM = false, AFTER_DRAIN = false, MIDHOOK = false, HASINIT = true; static constexpr int NSTORES = 0;
    static __device__ __forceinline__ int nstores(const Unit&) { return 0; }
    const float* base; float* out; bf16_t* xb; float* ss;
    __device__ __forceinline__ void init(f32x4 (&acc)[2][2][4][2], const Unit& u, int wr, int wc, int fr, int fq) const {
        int row0 = u.pm * BM + wr * 64 + fr; asm volatile("" : "+v"(row0)); const int col0 = u.pn * BM + wc * 32 + 4 * fq;
#pragma unroll
        for (int ai = 0; ai < 2; ++ai)
#pragma unroll
            for (int m = 0; m < 4; ++m) { const size_t off = (size_t)(row0 + ai * HALF + m * 16) * 1024 + col0;
#pragma unroll
                for (int bj = 0; bj < 2; ++bj)
#pragma unroll
                    for (int n = 0; n < 2; ++n) acc[ai][bj][m][n] = *(const f32x4*)(base + off + bj * HALF + n * 16); }
    }
    __device__ __forceinline__ void operator()(const f32x4 (&acc)[2][2][4][2], const Unit& u, int wr, int wc, int fr, int fq) const {
        typedef unsigned u32x2v __attribute__((ext_vector_type(2)));
        int row0 = u.pm * BM + wr * 64 + fr; asm volatile("" : "+v"(row0)); const int col0 = u.pn * BM + wc * 32 + 4 * fq;
#pragma unroll
        for (int ai = 0; ai < 2; ++ai)
#pragma unroll
            for (int m = 0; m < 4; ++m) { const int row = row0 + ai * HALF + m * 16; const size_t off = (size_t)row * 1024 + col0; float s = 0.f;
#pragma unroll
                for (int bj = 0; bj < 2; ++bj)
#pragma unroll
                    for (int n = 0; n < 2; ++n) { const f32x4 v = acc[ai][bj][m][n] * 1.0f;
                        *(f32x4*)(out + off + bj * HALF + n * 16) = v; u32x2v w; w.x = cvt_pk_bf16c(v[0], v[1]); w.y = cvt_pk_bf16c(v[2], v[3]);
                        if (xb) *(u32x2v*)(xb + off + bj * HALF + n * 16) = w; s += (v[0] * v[0] + v[1] * v[1]) + (v[2] * v[2] + v[3] * v[3]); }
                s += __shfl_xor(s, 16); s += __shfl_xor(s, 32);
                if (fq == 0) __hip_atomic_fetch_add(ss + row, s, __ATOMIC_RELAXED, __HIP_MEMORY_SCOPE_AGENT); }
    }
};

template <class Epi, class Sched, bool ALIGN_EPI = false, bool SP2 = false>
__device__ __forceinline__ void gemm_phase(PG8_LAS unsigned char* lds, const Gemm g, const Sched& S, const Epi& E) {
    int tid_ = threadIdx.x; asm volatile("" : "+v"(tid_));
    const int tid = tid_, wid = __builtin_amdgcn_readfirstlane(tid >> 6), lane = tid & 63, wr = wid >> 2, wc = wid & 3, fr = lane & 15, fq = lane >> 4;
    const int K = g.K, nt = K / BK;
    unsigned voffA[2], voffB[2];
#pragma unroll
    for (int i = 0; i < 2; ++i) { int R, C; stage_rc(tid * 16 + i * 8192, R, C); const int Rb = Epi::PERM ? ((R & ~31) + perm32(R & 31)) : R;
        voffA[i] = (unsigned)(R * K + C) * 2u; voffB[i] = (unsigned)(Rb * K + C) * 2u; }
    const size_t kstep = (size_t)(BK * 2);
    const size_t hstep = (size_t)HALF * K * 2;
    const size_t tstep = 2 * hstep;
    const unsigned ldsw = (unsigned)wid * 1024u;
    const int aoff = lds_byte(wr * 64 + fr, fq * 8), boff = lds_byte(wc * 32 + fr, fq * 8);
#define PG8_SA(b, h) (((b) * 2 + (h)) * HTB)
#define PG8_SB(b, h) ((4 + (b) * 2 + (h)) * HTB)
#define PG8_STAGE(bufoff, gbase, voff) do { _Pragma("unroll") for (int _i = 0; _i < 2; ++_i) \
        __builtin_amdgcn_global_load_lds((const unsigned*)((const char*)(gbase) + (voff)[_i]), (PG8_LAS unsigned*)(lds + (bufoff) + ldsw + _i * 8192), 16, 0, 0); } while (0)
#define PG8_LDA(dst, b, h) do { _Pragma("unroll") for (int m = 0; m < 4; ++m) _Pragma("unroll") for (int k = 0; k < 2; ++k) dst[m][k] = *(const PG8_LAS bf16x8*)(lds + PG8_SA(b, h) + aoff + m * 2048 + k * 1024); } while (0)
#define PG8_LDB(dst, b, h) do { _Pragma("unroll") for (int n = 0; n < 2; ++n) _Pragma("unroll") for (int k = 0; k < 2; ++k) dst[n][k] = *(const PG8_LAS bf16x8*)(lds + PG8_SB(b, h) + boff + n * 2048 + k * 1024); } while (0)
#define PG8_MMA(ai, bj, At, Bt) do { __builtin_amdgcn_s_setprio(1); _Pragma("unroll") for (int m = 0; m < 4; ++m) _Pragma("unroll") for (int n = 0; n < 2; ++n) _Pragma("unroll") for (int k = 0; k < 2; ++k) \
        acc[ai][bj][m][n] = __builtin_amdgcn_mfma_f32_16x16x32_bf16(Bt[n][k], At[m][k], acc[ai][bj][m][n], 0, 0, 0); __builtin_amdgcn_s_setprio(0); } while (0)
#define PG8_WAIT_V(n) asm volatile("s_waitcnt vmcnt(" #n ")" ::: "memory")
#define PG8_WAIT_L(n) asm volatile("s_waitcnt lgkmcnt(" #n ")" ::: "memory")
#define PG8_BAR __builtin_amdgcn_s_barrier()
#define PG8_SCHED __builtin_amdgcn_sched_barrier(0)
    Unit cur, nxt; int ui = 0;
    if (!S.next(0, cur)) return;
    f32x4 acc[2][2][4][2];
    if constexpr (Epi::HASINIT) E.init(acc, cur, wr, wc, fr, fq);
    else {
#pragma unroll
    for (int a = 0; a < 2; ++a)
#pragma unroll
        for (int b = 0; b < 2; ++b)
#pragma unroll
            for (int m = 0; m < 4; ++m)
#pragma unroll
                for (int n = 0; n < 2; ++n) acc[a][b][m][n] = (f32x4){0.f, 0.f, 0.f, 0.f};
    }
    bf16x8 At[4][2], B0[2][2], B1[2][2];
    const char* cA = (const char*)g.A + (size_t)cur.pm * tstep; const char* cB = (const char*)g.Bt + (size_t)cur.pn * tstep;
    S.a_ready(cur);
    if constexpr (SP2) {
        PG8_STAGE(PG8_SB(0, 0), cB, voffB); PG8_STAGE(PG8_SB(0, 1), cB + hstep, voffB); PG8_STAGE(PG8_SA(0, 0), cA, voffA); PG8_STAGE(PG8_SA(0, 1), cA + hstep, voffA);
        if (wr == 1) PG8_BAR;
        PG8_WAIT_V(2); PG8_BAR;
        PG8_STAGE(PG8_SB(1, 0), cB + kstep, voffB); PG8_STAGE(PG8_SA(1, 0), cA + kstep, voffA); PG8_STAGE(PG8_SB(1, 1), cB + hstep + kstep, voffB);
        PG8_WAIT_V(6); PG8_BAR;
    } else {
        PG8_STAGE(PG8_SB(0, 0), cB, voffB); PG8_STAGE(PG8_SA(0, 0), cA, voffA); PG8_STAGE(PG8_SB(0, 1), cB + hstep, voffB); PG8_STAGE(PG8_SA(0, 1), cA + hstep, voffA);
        if (wr == 1) PG8_BAR;
        PG8_WAIT_V(4); PG8_BAR;
        PG8_STAGE(PG8_SB(1, 0), cB + kstep, voffB); PG8_STAGE(PG8_SA(1, 0), cA + kstep, voffA); PG8_STAGE(PG8_SB(1, 1), cB + hstep + kstep, voffB);
        PG8_WAIT_V(6); PG8_BAR;
    }
    for (;;) {
        const bool has_next = S.next(ui + 1, nxt);
        const char* nA = has_next ? (const char*)g.A + (size_t)nxt.pm * tstep : cA; const char* nB = has_next ? (const char*)g.Bt + (size_t)nxt.pn * tstep : cB;
        for (int t = 0; t < nt; t += 2) {
            const bool last = (t == nt - 2);
            const char* a1 = cA + (size_t)(t + 1) * kstep;
            const char* a2 = last ? nA : cA + (size_t)(t + 2) * kstep; const char* b2 = last ? nB : cB + (size_t)(t + 2) * kstep;
            const char* a3 = a2 + kstep; const char* b3 = b2 + kstep;
            if (last && has_next) S.a_ready(nxt);
            if constexpr (Epi::MIDHOOK) { if (t == (nt >> 1)) E.mid(acc, cur, wr, wc, fr, fq); }
            if constexpr (SP2) {
            PG8_LDB(B0, 0, 0); PG8_LDB(B1, 0, 1); PG8_SCHED; PG8_LDA(At, 0, 0); PG8_STAGE(PG8_SA(1, 1), a1 + hstep, voffA);
            PG8_WAIT_V(8); PG8_WAIT_L(0); PG8_BAR; PG8_MMA(0, 0, At, B0); PG8_MMA(0, 1, At, B1); PG8_BAR; PG8_SCHED;
            PG8_LDA(At, 0, 1); PG8_STAGE(PG8_SB(0, 0), b2, voffB); PG8_STAGE(PG8_SB(0, 1), b2 + hstep, voffB); PG8_STAGE(PG8_SA(0, 0), a2, voffA);
            PG8_WAIT_V(8); PG8_WAIT_L(0); PG8_BAR; PG8_MMA(1, 0, At, B0); PG8_MMA(1, 1, At, B1); PG8_BAR; PG8_SCHED;
            PG8_LDB(B0, 1, 0); PG8_LDB(B1, 1, 1); PG8_SCHED; PG8_LDA(At, 1, 0); PG8_STAGE(PG8_SA(0, 1), a2 + hstep, voffA);
            PG8_WAIT_V(8); PG8_WAIT_L(0); PG8_BAR; PG8_MMA(0, 0, At, B0); PG8_MMA(0, 1, At, B1); PG8_BAR; PG8_SCHED;
            PG8_LDA(At, 1, 1); PG8_STAGE(PG8_SB(1, 0), b3, voffB); PG8_STAGE(PG8_SB(1, 1), b3 + hstep, voffB); PG8_STAGE(PG8_SA(1, 0), a3, voffA);
            PG8_WAIT_V(8); PG8_WAIT_L(0); PG8_BAR; PG8_MMA(1, 0, At, B0); PG8_MMA(1, 1, At, B1); PG8_BAR; PG8_SCHED;
            } else {
            PG8_LDB(B0, 0, 0); PG8_SCHED; PG8_LDA(At, 0, 0); PG8_STAGE(PG8_SA(1, 1), a1 + hstep, voffA);
            PG8_WAIT_L(8); PG8_BAR; PG8_WAIT_L(0); PG8_MMA(0, 0, At, B0); PG8_BAR; PG8_SCHED;
            PG8_LDB(B1, 0, 1); PG8_STAGE(PG8_SB(0, 0), b2, voffB);
            PG8_BAR; PG8_WAIT_L(0); PG8_MMA(0, 1, At, B1); PG8_BAR;
            PG8_LDA(At, 0, 1); PG8_STAGE(PG8_SA(0, 0), a2, voffA);
            PG8_BAR; PG8_WAIT_L(0); PG8_MMA(1, 0, At, B0); PG8_BAR; PG8_SCHED;
            PG8_STAGE(PG8_SB(0, 1), b2 + hstep, voffB);
            PG8_WAIT_V(6); PG8_BAR; PG8_MMA(1, 1, At, B1); PG8_BAR;
            PG8_LDB(B0, 1, 0); PG8_SCHED; PG8_LDA(At, 1, 0); PG8_STAGE(PG8_SA(0, 1), a2 + hstep, voffA);
            PG8_WAIT_L(8); PG8_BAR; PG8_WAIT_L(0); PG8_MMA(0, 0, At, B0); PG8_BAR; PG8_SCHED;
            PG8_LDB(B1, 1, 1); PG8_STAGE(PG8_SB(1, 0), b3, voffB);
            PG8_BAR; PG8_WAIT_L(0); PG8_MMA(0, 1, At, B1); PG8_BAR;
            PG8_LDA(At, 1, 1); PG8_STAGE(PG8_SA(1, 0), a3, voffA);
            PG8_BAR; PG8_WAIT_L(0); PG8_MMA(1, 0, At, B0); PG8_BAR; PG8_SCHED;
            PG8_STAGE(PG8_SB(1, 1), b3 + hstep, voffB);
            PG8_WAIT_V(6); PG8_BAR; PG8_MMA(1, 1, At, B1); PG8_BAR;
            }
        }
        if constexpr (ALIGN_EPI) { if (wr == 0) PG8_BAR; }
        if constexpr (!Epi::AFTER_DRAIN) { E(acc, cur, wr, wc, fr, fq); S.done(cur); }
        if (!has_next) break;
        if constexpr (Epi::HASINIT) E.init(acc, nxt, wr, wc, fr, fq);
        else {
#pragma unroll
        for (int a = 0; a < 2; ++a)
#pragma unroll
            for (int b = 0; b < 2; ++b)
#pragma unroll
                for (int m = 0; m < 4; ++m)
#pragma unroll
                    for (int n = 0; n < 2; ++n) acc[a][b][m][n] = (f32x4){0.f, 0.f, 0.f, 0.f};
        }
        cur = nxt; cA = nA; cB = nB; ++ui;
        if constexpr (ALIGN_EPI) { if (wr == 1) PG8_BAR; }
    }
    PG8_WAIT_V(0);
    if constexpr (!ALIGN_EPI) { if (wr == 0) PG8_BAR; }
    PG8_BAR;
    if constexpr (Epi::AFTER_DRAIN) { E.fused(acc, cur, wr, wc, fr, fq, lds, wid, lane); S.done(cur); }
#undef PG8_SA
#undef PG8_SB
#undef PG8_STAGE
#undef PG8_LDA
#undef PG8_LDB
#undef PG8_MMA
#undef PG8_WAIT_V
#undef PG8_WAIT_L
#undef PG8_BAR
#undef PG8_SCHED
}
}

constexpr int D = 1024, SEQ = 4096, NB = 8, DIN = 8192, FF = 4096, DEPTH = 2, CH = 128, NCH = SEQ / CH, NH = 4;
constexpr int HB = 4;
constexpr int MH = HB * SEQ;
constexpr int C_CB = 0, C_CC = 1024, C_CU = 2048, C_Q = 3072, C_K = 3584, C_V = 4096, C_G = 5120;
constexpr size_t MiB = 1u << 20;
constexpr size_t WS_SS = 0;
constexpr size_t WS_BAR = 1 * MiB, BAR_BYTES = 16384;
constexpr size_t WS_W = 2 * MiB;
constexpr size_t W_LAYER = 38 * MiB, W_IN = 0, W_CR = 16 * MiB, W_O = 20 * MiB, W_UP = 22 * MiB, W_DN = 30 * MiB;
constexpr size_t WS_XB = 80 * MiB;
constexpr size_t WS_AB = 112 * MiB;
constexpr size_t WS_KV = WS_AB;
constexpr size_t WS_MG = 176 * MiB;
constexpr size_t WS_ST = 208 * MiB;
constexpr size_t WS_PROJ = 240 * MiB;
constexpr size_t WS_U = WS_PROJ;
constexpr size_t WS_ROT = 496 * MiB;
constexpr size_t WS_END = 504 * MiB;
constexpr int LDS_BYTES = 147456;
constexpr int NWAVES = 8, NT = 512;

#define LAS __attribute__((address_space(3)))
typedef unsigned short bf16;
typedef unsigned u32x4 __attribute__((ext_vector_type(4)));
typedef unsigned u32x2 __attribute__((ext_vector_type(2)));
typedef float f32x4 __attribute__((ext_vector_type(4)));
typedef short bf16x8 __attribute__((ext_vector_type(8)));
#define LDS_WAIT() asm volatile("s_waitcnt lgkmcnt(0)" ::: "memory")

__device__ __forceinline__ unsigned pk2(float lo, float hi) { return pg8::cvt_pk_bf16(lo, hi); }
typedef float f32x2c __attribute__((ext_vector_type(2)));
typedef __bf16 bf16x2c __attribute__((ext_vector_type(2)));
__device__ __forceinline__ unsigned pk2c(float lo, float hi) { const f32x2c v = {lo, hi}; return __builtin_bit_cast(unsigned, __builtin_convertvector(v, bf16x2c)); }
__device__ __forceinline__ float bflo(unsigned w) { return __uint_as_float(w << 16); }
__device__ __forceinline__ float bfhi(unsigned w) { return __uint_as_float(w & 0xffff0000u); }
__device__ __forceinline__ float wave_sum(float v) {
#pragma unroll
    for (int o = 1; o < 64; o <<= 1) v += __shfl_xor(v, o);
    return v;
}
__device__ __forceinline__ float ex2(float x) { return __builtin_amdgcn_exp2f(x); }

__device__ __forceinline__ void transpose_item(const float* W, int K, int N, bf16* WT, int ldk, int col_off, const float* kscale, LAS float* scr, int item, int lane, bool zmap = false) {
    const int nblk = N / 64, kb = item / nblk, nb = item % nblk, k0 = 64 * kb, n0 = 64 * nb;
    int nd0 = n0;
    if (zmap && n0 >= 1024 && n0 < 3072) { const int ch = (n0 - 1024) & 1023; nd0 = 1024 + 256 * (ch >> 7) + (n0 >= 2048 ? 128 : 0) + (ch & 127); }
    const int n4 = (lane & 15) * 4;
#pragma unroll 8
    for (int i = 0; i < 16; ++i) { const int kk = 4 * i + (lane >> 4); f32x4 v = *(const f32x4*)(W + (size_t)(k0 + kk) * N + n0 + n4); if (kscale) v = v * kscale[k0 + kk];
        LAS float* d = scr + kk * 65 + n4; d[0] = v[0]; d[1] = v[1]; d[2] = v[2]; d[3] = v[3]; }
    LDS_WAIT(); asm volatile("" ::: "memory");
    const int c = lane & 7;
#pragma unroll
    for (int j = 0; j < 8; ++j) { const int n = (lane >> 3) + 8 * j; const LAS float* s = scr + (8 * c) * 65 + n;
        u32x4 o; o.x = pk2(s[0 * 65], s[1 * 65]); o.y = pk2(s[2 * 65], s[3 * 65]); o.z = pk2(s[4 * 65], s[5 * 65]); o.w = pk2(s[6 * 65], s[7 * 65]);
        *(u32x4*)(WT + (size_t)(nd0 + n) * ldk + col_off + k0 + 8 * c) = o; }
    LDS_WAIT(); asm volatile("" ::: "memory");
}

constexpr int RS = 136;
__device__ __forceinline__ int ppos(int t) { const int k = t & 31; return (t & ~31) + 8 * ((k >> 2) & 3) + 4 * (k >> 4) + (k & 3); }
struct RawRow { u32x4 a0, a1, b0, b1; };
struct RawV { u32x4 a[4], b[4]; };
struct RawCs { f32x4 t[8]; };
__device__ __forceinline__ RawRow ld_row(const bf16* rowp, int c) { RawRow r; r.a0 = *(const u32x4*)(rowp + 16 * c); r.a1 = *(const u32x4*)(rowp + 16 * c + 8); r.b0 = *(const u32x4*)(rowp + 64 + 16 * c); r.b1 = *(const u32x4*)(rowp + 64 + 16 * c + 8); return r; }
__device__ __forceinline__ RawCs ld_cs(const float* cs, int c) { RawCs r; const f32x4* tp = (const f32x4*)(cs + 32 * c);
#pragma unroll
    for (int i = 0; i < 8; ++i) r.t[i] = tp[i];
    return r; }
__device__ __forceinline__ RawV ld_v(const bf16* vbase, int tid) { RawV r; const int tp = tid >> 3, c = tid & 7; const bf16* v0 = vbase + (size_t)(2 * tp) * DIN;
#pragma unroll
    for (int u = 0; u < 4; ++u) { const int dv0 = 8 * (c + 8 * u); r.a[u] = *(const u32x4*)(v0 + dv0); r.b[u] = *(const u32x4*)(v0 + DIN + dv0); }
    return r; }
__device__ __forceinline__ void unpack16(const u32x4 a, const u32x4 b, float (&o)[16]) {
#pragma unroll
    for (int i = 0; i < 4; ++i) { o[2 * i] = bflo(a[i]); o[2 * i + 1] = bfhi(a[i]); o[8 + 2 * i] = bflo(b[i]); o[8 + 2 * i + 1] = bfhi(b[i]); }
}
__device__ __forceinline__ void rot_apply(const RawRow& rw, const RawCs& cs, float scale, float (&o1)[16], float (&o2)[16]) {
    float a[16], b[16]; unpack16(rw.a0, rw.a1, a); unpack16(rw.b0, rw.b1, b);
#pragma unroll
    for (int i = 0; i < 8; ++i) { const f32x4 t = cs.t[i];
        o1[2 * i] = (a[2 * i] * t[0] - b[2 * i] * t[1]) * scale; o2[2 * i] = (a[2 * i] * t[1] + b[2 * i] * t[0]) * scale;
        o1[2 * i + 1] = (a[2 * i + 1] * t[2] - b[2 * i + 1] * t[3]) * scale; o2[2 * i + 1] = (a[2 * i + 1] * t[3] + b[2 * i + 1] * t[2]) * scale; }
}
__device__ __forceinline__ void stage_vt(LAS bf16* Vt, const RawV& rv, int tid) {
    const int tp = tid >> 3, c = tid & 7, p0 = ppos(2 * tp);
#pragma unroll
    for (int u = 0; u < 4; ++u) { const int dv0 = 8 * (c + 8 * u); const u32x4 a = rv.a[u], b = rv.b[u];
#pragma unroll
        for (int e = 0; e < 8; ++e) { const unsigned lo = (e & 1) ? (a[e >> 1] >> 16) : (a[e >> 1] & 0xffffu), hi = (e & 1) ? (b[e >> 1] & 0xffff0000u) : (b[e >> 1] << 16);
            *(LAS unsigned*)(Vt + (dv0 + e) * RS + p0) = lo | hi; } }
}
__device__ __forceinline__ void kv_item(LAS unsigned char* lds, const bf16* proj, const float* rot, bf16* KV, int rowbase, int h, float log2g, int tid) {
    asm volatile("" : "+v"(tid));
    LAS bf16* Vt = (LAS bf16*)lds; LAS bf16* Kt = Vt + 256 * RS;
    const RawV rv = ld_v(proj + (size_t)rowbase * DIN + C_V + h * 256, tid);
    const RawRow rk = ld_row(proj + (size_t)(rowbase + (tid >> 2)) * DIN + C_K + h * 128, tid & 3);
    const RawCs rc = ld_cs(rot + (size_t)(rowbase + (tid >> 2)) * 128, tid & 3);
    stage_vt(Vt, rv, tid);
    { const int t = tid >> 2, c = tid & 3; float o1[16], o2[16];
      rot_apply(rk, rc, ex2(log2g * (float)(127 - t)), o1, o2);
      const int p = ppos(t);
#pragma unroll
      for (int i = 0; i < 16; ++i) { Kt[(16 * c + i) * RS + p] = (bf16)(pk2(o1[i], 0.f) & 0xffffu); Kt[(64 + 16 * c + i) * RS + p] = (bf16)(pk2(o2[i], 0.f) & 0xffffu); } }
    __syncthreads();
    const int w = __builtin_amdgcn_readfirstlane(tid >> 6), l = tid & 63, fr = l & 15, fq = l >> 4;
    f32x4 acc[2][8];
#pragma unroll
    for (int mi = 0; mi < 2; ++mi)
#pragma unroll
        for (int nt = 0; nt < 8; ++nt) acc[mi][nt] = (f32x4){0.f, 0.f, 0.f, 0.f};
#pragma unroll
    for (int s = 0; s < 4; ++s) { bf16x8 a[2];
#pragma unroll
        for (int mi = 0; mi < 2; ++mi) a[mi] = *(const LAS bf16x8*)(Vt + (16 * (2 * w + mi) + fr) * RS + 32 * s + 8 * fq);
#pragma unroll
        for (int nt = 0; nt < 8; ++nt) { const bf16x8 b = *(const LAS bf16x8*)(Kt + (16 * nt + fr) * RS + 32 * s + 8 * fq);
#pragma unroll
            for (int mi = 0; mi < 2; ++mi) acc[mi][nt] = __builtin_amdgcn_mfma_f32_16x16x32_bf16(b, a[mi], acc[mi][nt], 0, 0, 0); } }
#pragma unroll
    for (int mi = 0; mi < 2; ++mi)
#pragma unroll
        for (int nt = 0; nt < 8; ++nt)
            { u32x2 o; o.x = pk2c(acc[mi][nt][0], acc[mi][nt][1]); o.y = pk2c(acc[mi][nt][2], acc[mi][nt][3]); *(u32x2*)(KV + (size_t)(16 * (2 * w + mi) + fr) * 128 + 16 * nt + 4 * fq) = o; }
    __syncthreads();
}
__device__ __forceinline__ void ret_item(LAS unsigned char* lds, const bf16* proj, const float* rot, const bf16* St, bf16* AB, int rowbase, int h, float log2g, int tid) {
    asm volatile("" : "+v"(tid));
    LAS bf16* Qs = (LAS bf16*)lds; LAS bf16* Ks = Qs + 128 * RS; LAS bf16* Vt = Ks + 128 * RS;
    u32x4 stp[8];
#pragma unroll
    for (int it = 0; it < 8; ++it) { const int idx = tid + it * NT; stp[it] = *(const u32x4*)(St + (idx >> 4) * 128 + 8 * (idx & 15)); }
    const RawV rv = ld_v(proj + (size_t)rowbase * DIN + C_V + h * 256, tid);
    const RawRow rq = ld_row(proj + (size_t)(rowbase + (tid >> 2)) * DIN + C_Q + h * 128, tid & 3);
    const RawRow rk = ld_row(proj + (size_t)(rowbase + (tid >> 2)) * DIN + C_K + h * 128, tid & 3);
    const RawCs rc = ld_cs(rot + (size_t)(rowbase + (tid >> 2)) * 128, tid & 3);
    stage_vt(Vt, rv, tid);
    { const int t = tid >> 2, c = tid & 3; float o1[16], o2[16];
      rot_apply(rq, rc, 0.08838834764831845f, o1, o2);
      u32x4 w0, w1, w2, w3;
#pragma unroll
      for (int i = 0; i < 4; ++i) { w0[i] = pk2(o1[2 * i], o1[2 * i + 1]); w1[i] = pk2(o1[8 + 2 * i], o1[8 + 2 * i + 1]); w2[i] = pk2(o2[2 * i], o2[2 * i + 1]); w3[i] = pk2(o2[8 + 2 * i], o2[8 + 2 * i + 1]); }
      *(LAS u32x4*)(Qs + t * RS + 16 * c) = w0; *(LAS u32x4*)(Qs + t * RS + 16 * c + 8) = w1; *(LAS u32x4*)(Qs + t * RS + 64 + 16 * c) = w2; *(LAS u32x4*)(Qs + t * RS + 64 + 16 * c + 8) = w3;
      rot_apply(rk, rc, 1.0f, o1, o2);
#pragma unroll
      for (int i = 0; i < 4; ++i) { w0[i] = pk2(o1[2 * i], o1[2 * i + 1]); w1[i] = pk2(o1[8 + 2 * i], o1[8 + 2 * i + 1]); w2[i] = pk2(o2[2 * i], o2[2 * i + 1]); w3[i] = pk2(o2[8 + 2 * i], o2[8 + 2 * i + 1]); }
      *(LAS u32x4*)(Ks + t * RS + 16 * c) = w0; *(LAS u32x4*)(Ks + t * RS + 16 * c + 8) = w1; *(LAS u32x4*)(Ks + t * RS + 64 + 16 * c) = w2; *(LAS u32x4*)(Ks + t * RS + 64 + 16 * c + 8) = w3; }
    __syncthreads();
    const int w = __builtin_amdgcn_readfirstlane(tid >> 6), l = tid & 63, fr = l & 15, fq = l >> 4;
    bf16x8 qf[4];
#pragma unroll
    for (int s = 0; s < 4; ++s) qf[s] = *(const LAS bf16x8*)(Qs + (16 * w + fr) * RS + 32 * s + 8 * fq);
    f32x4 sc[8];
#pragma unroll
    for (int kt = 0; kt < 8; ++kt) { sc[kt] = (f32x4){0.f, 0.f, 0.f, 0.f};
        if (kt <= w) {
#pragma unroll
            for (int s = 0; s < 4; ++s) { const bf16x8 a = *(const LAS bf16x8*)(Ks + (16 * kt + fr) * RS + 32 * s + 8 * fq); sc[kt] = __builtin_amdgcn_mfma_f32_16x16x32_bf16(a, qf[s], sc[kt], 0, 0, 0); } } }
    const int q = 16 * w + fr;
    bf16x8 pf[4];
#pragma unroll
    for (int s2 = 0; s2 < 4; ++s2) { float v[8];
#pragma unroll
        for (int hh = 0; hh < 2; ++hh)
#pragma unroll
            for (int r = 0; r < 4; ++r) { const int kt = 2 * s2 + hh, d = q - (16 * kt + 4 * fq + r); v[4 * hh + r] = (d >= 0) ? sc[kt][r] * ex2(log2g * (float)d) : 0.f; }
        u32x4 pw; pw.x = pk2(v[0], v[1]); pw.y = pk2(v[2], v[3]); pw.z = pk2(v[4], v[5]); pw.w = pk2(v[6], v[7]); pf[s2] = __builtin_bit_cast(bf16x8, pw); }
    f32x4 accA[16];
#pragma unroll
    for (int mt = 0; mt < 16; ++mt) accA[mt] = (f32x4){0.f, 0.f, 0.f, 0.f};
#pragma unroll
    for (int s2 = 0; s2 < 4; ++s2) { if (s2 <= (w >> 1)) {
#pragma unroll
        for (int mt = 0; mt < 16; ++mt) { const bf16x8 a = *(const LAS bf16x8*)(Vt + (16 * mt + fr) * RS + 32 * s2 + 8 * fq); accA[mt] = __builtin_amdgcn_mfma_f32_16x16x32_bf16(a, pf[s2], accA[mt], 0, 0, 0); } } }
    __syncthreads();
#pragma unroll
    for (int it = 0; it < 8; ++it) { const int idx = tid + it * NT, dv = idx >> 4, ch = idx & 15; *(LAS u32x4*)(Vt + dv * RS + 8 * ch) = stp[it]; }
    const int qg = 16 * w + fr;
    const bf16* gp = proj + (size_t)(rowbase + qg) * DIN + C_G + h * 256 + 4 * fq;
    u32x2 gpre[16];
#pragma unroll
    for (int mt = 0; mt < 16; ++mt) gpre[mt] = *(const u32x2*)(gp + 16 * mt);
    __syncthreads();
    f32x4 accB[16];
#pragma unroll
    for (int mt = 0; mt < 16; ++mt) accB[mt] = (f32x4){0.f, 0.f, 0.f, 0.f};
#pragma unroll
    for (int s = 0; s < 4; ++s)
#pragma unroll
        for (int mt = 0; mt < 16; ++mt) { const bf16x8 a = *(const LAS bf16x8*)(Vt + (16 * mt + fr) * RS + 32 * s + 8 * fq); accB[mt] = __builtin_amdgcn_mfma_f32_16x16x32_bf16(a, qf[s], accB[mt], 0, 0, 0); }
    const float dq = ex2(log2g * (float)(q + 1));
    float sum = 0.f;
#pragma unroll
    for (int mt = 0; mt < 16; ++mt) { accA[mt] = accA[mt] + accB[mt] * dq; sum += (accA[mt][0] + accA[mt][1]) + (accA[mt][2] + accA[mt][3]); }
    sum += __shfl_xor(sum, 16); sum += __shfl_xor(sum, 32);
    const float mu = sum * (1.0f / 256.0f); float var = 0.f;
#pragma unroll
    for (int mt = 0; mt < 16; ++mt) { accA[mt] = accA[mt] - mu; var += (accA[mt][0] * accA[mt][0] + accA[mt][1] * accA[mt][1]) + (accA[mt][2] * accA[mt][2] + accA[mt][3] * accA[mt][3]); }
    var += __shfl_xor(var, 16); var += __shfl_xor(var, 32);
    const float rstd = rsqrtf(var * (1.0f / 256.0f) + pg8::NORM_EPS);
    const size_t R = (size_t)(rowbase + q);
    bf16* op = AB + R * 2048 + 1024 + h * 256 + 4 * fq;
#pragma unroll
    for (int mt = 0; mt < 16; ++mt) { const u32x2 g2 = gpre[mt]; const float g0 = bflo(g2.x), g1 = bfhi(g2.x), g2f = bflo(g2.y), g3 = bfhi(g2.y);
        const float y0 = accA[mt][0] * rstd * g0 * __builtin_amdgcn_rcpf(1.f + __expf(-g0)), y1 = accA[mt][1] * rstd * g1 * __builtin_amdgcn_rcpf(1.f + __expf(-g1)), y2 = accA[mt][2] * rstd * g2f * __builtin_amdgcn_rcpf(1.f + __expf(-g2f)), y3 = accA[mt][3] * rstd * g3 * __builtin_amdgcn_rcpf(1.f + __expf(-g3));
        u32x2 o; o.x = pk2(y0, y1); o.y = pk2(y2, y3); *(u32x2*)(op + 16 * mt) = o; }
    __syncthreads();
}
__device__ __forceinline__ void conv_item(const bf16* proj, bf16* AB, const float* cw, int ci, int tid) {
    asm volatile("" : "+v"(tid));
    const int c0 = (tid & 127) * 8, t0 = ci * 64 + (tid >> 7) * 16;
    float w0[8], w1[8], w2[8], z1[8], z2[8];
#pragma unroll
    for (int e = 0; e < 8; ++e) { w0[e] = cw[c0 + e]; w1[e] = cw[1024 + c0 + e]; w2[e] = cw[2048 + c0 + e]; z1[e] = 0.f; z2[e] = 0.f; }
    if ((t0 & (SEQ - 1)) != 0) {
        const bf16* p2 = proj + (size_t)(t0 - 2) * DIN + C_CC + c0;
        const u32x4 a2 = *(const u32x4*)p2, a1 = *(const u32x4*)(p2 + DIN);
#pragma unroll
        for (int i = 0; i < 4; ++i) { z2[2 * i] = bflo(a2[i]); z2[2 * i + 1] = bfhi(a2[i]); z1[2 * i] = bflo(a1[i]); z1[2 * i + 1] = bfhi(a1[i]); }
    }
#pragma unroll 1
    for (int tb = 0; tb < 16; tb += 8) { u32x4 vb[8], vz[8];
#pragma unroll
        for (int tt = 0; tt < 8; ++tt) { const bf16* p = proj + (size_t)(t0 + tb + tt) * DIN + c0; vb[tt] = *(const u32x4*)(p + C_CB); vz[tt] = *(const u32x4*)(p + C_CC); }
#pragma unroll
        for (int tt = 0; tt < 8; ++tt) { float z[8], o[8];
#pragma unroll
            for (int i = 0; i < 4; ++i) { z[2 * i] = bflo(vz[tt][i]); z[2 * i + 1] = bfhi(vz[tt][i]); }
#pragma unroll
            for (int i = 0; i < 4; ++i) { o[2 * i] = bflo(vb[tt][i]) * (w0[2 * i] * z2[2 * i] + w1[2 * i] * z1[2 * i] + w2[2 * i] * z[2 * i]);
                o[2 * i + 1] = bfhi(vb[tt][i]) * (w0[2 * i + 1] * z2[2 * i + 1] + w1[2 * i + 1] * z1[2 * i + 1] + w2[2 * i + 1] * z[2 * i + 1]); }
            u32x4 ow; ow.x = pk2(o[0], o[1]); ow.y = pk2(o[2], o[3]); ow.z = pk2(o[4], o[5]); ow.w = pk2(o[6], o[7]);
            *(u32x4*)(AB + (size_t)(t0 + tb + tt) * 2048 + c0) = ow;
#pragma unroll
            for (int e = 0; e < 8; ++e) { z2[e] = z1[e]; z1[e] = z[e]; } } }
}

#define XB_TMO      128
#define XB_XCNT(j)  (256  + 64 * (j))
#define XB_XSUB(j)  (1280 + 64 * (j))
#define XB_XGEN(j)  (2304 + 64 * (j))
#define XB_TOP      3328
#define XB_TOPGEN   3392
#define XCD_BAR_WORDS 3456
#define XB_SPIN_CAP (1u << 18)

__device__ __forceinline__ unsigned xb_ld(unsigned* p)              { return __hip_atomic_load(p, __ATOMIC_RELAXED, __HIP_MEMORY_SCOPE_AGENT); }
__device__ __forceinline__ unsigned xb_add(unsigned* p, unsigned v) { return __hip_atomic_fetch_add(p, v, __ATOMIC_RELAXED, __HIP_MEMORY_SCOPE_AGENT); }
__device__ __forceinline__ unsigned xb_xcc_id() { return (unsigned)__builtin_amdgcn_s_getreg((3 << 11) | 20) & 0xFu; }
#define XB_SPIN(cond, bar) do { unsigned _sp = 0; while (cond) { __builtin_amdgcn_s_sleep(1); \
    if ((++_sp & 255u) == 0u) { if (xb_ld(&(bar)[XB_TMO])) break; if (_sp > XB_SPIN_CAP) { atomicAdd(&(bar)[XB_TMO], 1u); break; } } } } while (0)

struct XcdBarrier {
    unsigned* bar; unsigned x;
    volatile LAS unsigned* st;
};

__device__ __forceinline__ XcdBarrier xcd_barrier_post(unsigned* bar, volatile LAS unsigned* st) {
    XcdBarrier b; b.bar = bar; b.x = xb_xcc_id(); b.st = st;
    if (threadIdx.x == 0) st[4] = xb_add(&bar[XB_XCNT(b.x)], 1u);
    return b;
}
__device__ __forceinline__ void xcd_barrier_complete(unsigned* bar, unsigned x, unsigned& nloc, unsigned& nx) {
    const unsigned G = gridDim.x * gridDim.y * gridDim.z;
    unsigned sum, cnt, mine, sp = 0u;
    for (;;) {
        sum = 0u; cnt = 0u; mine = 0u;
#pragma unroll
        for (unsigned j = 0; j < 16; ++j) { const unsigned c = xb_ld(&bar[XB_XCNT(j)]); sum += c; cnt += (c > 0u) ? 1u : 0u; mine = (j == x) ? c : mine; }
        if (sum == G) break;
        __builtin_amdgcn_s_sleep(1);
        if ((++sp & 255u) == 0u) { if (xb_ld(&bar[XB_TMO])) break; if (sp > XB_SPIN_CAP) { atomicAdd(&bar[XB_TMO], 1u); break; } }
    }
    nloc = mine > 0u ? mine : 1u; nx = cnt > 0u ? cnt : 1u;
}

__device__ __forceinline__ void xcd_barrier(const XcdBarrier& b) {
    asm volatile("s_waitcnt vmcnt(0)" ::: "memory");
    __syncthreads();
    if (threadIdx.x == 0) {
        unsigned* bar = b.bar;
        __builtin_amdgcn_s_waitcnt(0);
        unsigned nloc = b.st[0], nx = b.st[1];
        if (nloc == 0u) { xcd_barrier_complete(bar, b.x, nloc, nx); b.st[0] = nloc; b.st[1] = nx; }
        const unsigned old = xb_add(&bar[XB_XSUB(b.x)], 1u);
        const unsigned gen = old / nloc;
        if (old + 1u == (gen + 1u) * nloc) {
            __builtin_amdgcn_fence(__ATOMIC_RELEASE, "agent");
            asm volatile("s_waitcnt vmcnt(0)" ::: "memory");
            const unsigned og = xb_add(&bar[XB_TOP], 1u);
            const unsigned tg = og / nx;
            if (og + 1u == (tg + 1u) * nx) xb_add(&bar[XB_TOPGEN], 1u);
            else XB_SPIN(xb_ld(&bar[XB_TOPGEN]) == tg, bar);
            __builtin_amdgcn_fence(__ATOMIC_ACQUIRE, "agent");
            xb_add(&bar[XB_XGEN(b.x)], 1u);
            asm volatile("s_waitcnt vmcnt(0)" ::: "memory");
        } else {
            XB_SPIN(xb_ld(&bar[XB_XGEN(b.x)]) == gen, bar);
            __builtin_amdgcn_fence(__ATOMIC_ACQUIRE, "agent");
            asm volatile("s_waitcnt vmcnt(0)" ::: "memory");
        }
    }
    __syncthreads();
}


struct Args { const float* in[13]; float* out; unsigned char* ws; };
#define PH_P0 0
#define PH_PX 1
#define PH_P1 2
#define PH_P2A 3
#define PH_P2B 4
#define PH_P2C 5
#define PH_P3 6
#define PH_P4 7
#define PH_P5 8
#define PH_P6 9
#define PH_PF 10
#ifndef REPMASK
#define REPMASK 0
#endif
#ifdef XSYNC
#define GSYNC() do { xcd_barrier(xbar); xcd_barrier(xbar); } while (0)
#else
#define GSYNC() xcd_barrier(xbar)
#endif
#define REPS(id) (1 + (((REPMASK) >> (id)) & 1))
#ifdef PROBE_A
#define STAMP(id) do { const unsigned long long now_ = __builtin_amdgcn_s_memrealtime(); if (((PROBE_A) >> (id)) & 1) ta_ += now_ - tprev_; if (((PROBE_B) >> (id)) & 1) tb_ += now_ - tprev_; tprev_ = now_; } while (0)
#else
#define STAMP(id) do { } while (0)
#endif
__global__ void __launch_bounds__(NT, 2) hybrid_fwd(Args args) {
    extern __shared__ __attribute__((aligned(16))) unsigned char lds_raw[];
    LAS unsigned char* lds = (LAS unsigned char*)lds_raw;
    cg::grid_group grid = cg::this_grid();
    const int tid = threadIdx.x, lane = tid & 63, wave = __builtin_amdgcn_readfirstlane(tid >> 6);
    const int G = gridDim.x, bx = blockIdx.x;
    const int gw = bx * NWAVES + wave, NGW = G * NWAVES;
    unsigned char* ws = args.ws;
    volatile LAS unsigned* stw = (volatile LAS unsigned*)(lds + LDS_BYTES - 64);
    if (tid < 16) stw[tid] = (tid == 5) ? (unsigned)blockIdx.x : 0u;
    __syncthreads();
    const XcdBarrier xbar = xcd_barrier_post((unsigned*)(ws + WS_BAR), stw);
    const float* x_in = args.in[0]; const int* positions = (const int*)args.in[1];
    const float *norm_mix = args.in[2], *w_in = args.in[3], *conv_w = args.in[4], *w_conv_out = args.in[5], *ret_norm = args.in[6], *w_ret_out = args.in[7], *w_o = args.in[8],
                *norm_mlp = args.in[9], *w_up = args.in[10], *w_down = args.in[11], *norm_final = args.in[12];
    float* ssall = (float*)(ws + WS_SS);
    bf16* XB = (bf16*)(ws + WS_XB); bf16* AB = (bf16*)(ws + WS_AB); bf16* KV = (bf16*)(ws + WS_KV); bf16* MG = (bf16*)(ws + WS_MG); bf16* ST = (bf16*)(ws + WS_ST);
    bf16* PROJ = (bf16*)(ws + WS_PROJ); bf16* U = (bf16*)(ws + WS_U); float* ROT = (float*)(ws + WS_ROT);

#ifdef PROBE_A
    unsigned long long tprev_ = __builtin_amdgcn_s_memrealtime(), ta_ = 0, tb_ = 0;
#endif
    {
        LAS float* scr = (LAS float*)(lds + wave * 16640);
        constexpr int I_IN = 16 * 128, I_SQ = 16 * 16, I_UP = 16 * 64, I_DN = 64 * 16, I_LAYER = I_IN + 3 * I_SQ + I_UP + I_DN;
        for (int rep_ = 0; rep_ < REPS(PH_P0); ++rep_)
        for (int it = gw; it < DEPTH * I_LAYER; it += NGW) {
            const int L = it / I_LAYER; int r = it % I_LAYER; bf16* wl = (bf16*)(ws + WS_W + (size_t)L * W_LAYER);
            if (r < I_IN) { transpose_item(w_in + (size_t)L * D * DIN, D, DIN, (bf16*)((char*)wl + W_IN), D, 0, norm_mix + L * D, scr, r, lane, true); continue; } r -= I_IN;
            if (r < I_SQ) { transpose_item(w_conv_out + (size_t)L * D * D, D, D, (bf16*)((char*)wl + W_CR), 2048, 0, nullptr, scr, r, lane); continue; } r -= I_SQ;
            if (r < I_SQ) { transpose_item(w_ret_out + (size_t)L * D * D, D, D, (bf16*)((char*)wl + W_CR), 2048, 1024, ret_norm + L * D, scr, r, lane); continue; } r -= I_SQ;
            if (r < I_SQ) { transpose_item(w_o + (size_t)L * D * D, D, D, (bf16*)((char*)wl + W_O), D, 0, nullptr, scr, r, lane); continue; } r -= I_SQ;
            if (r < I_UP) { transpose_item(w_up + (size_t)L * D * FF, D, FF, (bf16*)((char*)wl + W_UP), D, 0, norm_mlp + L * D, scr, r, lane); continue; } r -= I_UP;
            transpose_item(w_down + (size_t)L * FF * D, FF, D, (bf16*)((char*)wl + W_DN), FF, 0, nullptr, scr, r, lane);
        }
        for (int i = bx * NT + tid; i < 2 * 4 * MH; i += G * NT) { const int hf = i / (4 * MH), r = i % (4 * MH); ssall[(size_t)hf * 5 * MH + MH + r] = 0.f; }
    }

    for (int hf = 0; hf < 2; ++hf) {
        float* ss = ssall + (size_t)hf * 5 * MH;
        const float* xh = x_in + (size_t)hf * MH * D; float* outh = args.out + (size_t)hf * MH * D;
        int lnx = lane; asm volatile("" : "+v"(lnx));
        for (int rep_ = 0; rep_ < REPS(PH_PX); ++rep_)
        for (int row0 = gw; row0 < MH; row0 += 4 * NGW) {
            f32x4 v[4][4];
#pragma unroll
            for (int k = 0; k < 4; ++k) { const int row = min(row0 + k * NGW, MH - 1); const f32x4* xr = (const f32x4*)(xh + (size_t)row * D) + lnx;
#pragma unroll
                for (int j = 0; j < 4; ++j) v[k][j] = xr[64 * j]; }
#pragma unroll
            for (int k = 0; k < 4; ++k) { const int row = row0 + k * NGW; if (row < MH) { float s = 0.f;
#pragma unroll
                for (int j = 0; j < 4; ++j) s += (v[k][j][0] * v[k][j][0] + v[k][j][1] * v[k][j][1]) + (v[k][j][2] * v[k][j][2] + v[k][j][3] * v[k][j][3]);
                s = wave_sum(s); if (lnx == 0) ss[row] = s;
                u32x2* o8 = (u32x2*)(XB + (size_t)row * D) + lnx;
#pragma unroll
                for (int j = 0; j < 4; ++j) { u32x2 o; o.x = pk2(v[k][j][0], v[k][j][1]); o.y = pk2(v[k][j][2], v[k][j][3]); o8[64 * j] = o; } } }
        }
        { int trt = tid; asm volatile("" : "+v"(trt));
          for (int idx = bx * NT + trt; idx < MH * 64; idx += G * NT) { const int row = idx >> 6, j = idx & 63;
              const float ang = (float)positions[(size_t)hf * MH + row] * ex2(-(float)j * 0.20762050593046014f);
              double rev = (double)ang * 0.15915494309189535; rev -= __builtin_rint(rev); const float fr = (float)rev;
              float2 o; o.x = __builtin_amdgcn_cosf(fr); o.y = __builtin_amdgcn_sinf(fr); *(float2*)(ROT + (size_t)idx * 2) = o; } }
        if (G == 0x7fffffff) grid.sync();
        GSYNC();
        if (hf == 0) {
            if (tid == 0) { unsigned* bar_ = (unsigned*)(ws + WS_BAR); unsigned lt = 0, npop = 0, uni = 1;
                for (unsigned j = 0; j < 16; ++j) { const unsigned cj = xb_ld(&bar_[XB_XCNT(j)]); if (cj) { ++npop; if (j < xbar.x) ++lt; if (cj * 8u != (unsigned)G) uni = 0; } }
                stw[5] = (uni && npop == 8u) ? lt + 8u * stw[4] : (unsigned)bx; }
            __syncthreads();
        }
        STAMP(PH_PX);
        for (int L = 0; L < DEPTH; ++L) {
            const unsigned char* wl = ws + WS_W + (size_t)L * W_LAYER;
            for (int rep_ = 0; rep_ < REPS(PH_P1); ++rep_) {
#ifdef P1_STAGGER
            { const unsigned long long t0_ = __builtin_amdgcn_s_memrealtime(), dl_ = (unsigned long long)(((bx >> 3) & 3) * P1_STAGGER);
              while (__builtin_amdgcn_s_memrealtime() - t0_ < dl_) __builtin_amdgcn_s_sleep(8); }
#endif
            { pg8::Gemm g{XB, (const bf16*)(wl + W_IN), MH, DIN, D}; pg8::StaticOrder S; S.init(MH, DIN, G, (int)__builtin_amdgcn_readfirstlane((int)stw[5]));
              pg8::Unit u0{0, 0}; (void)S.next(0, u0);
              LAS float* rtab = (LAS float*)(lds + 131072); { int tr_ = tid; asm volatile("" : "+v"(tr_)); if (tr_ < 256) rtab[tr_] = rsqrtf((ss + (2 * L) * MH)[u0.pm * 256 + tr_] * (1.0f / 1024.0f) + pg8::NORM_EPS); } __syncthreads();
              pg8::EpiScaleBf16<0, true, true> E{PROJ, DIN, ss + (2 * L) * MH, rtab, u0.pm};
#ifdef PROBE_NOSTORE
              if (rep_ == 1) { pg8::EpiScaleBf16<0, false> E2{PROJ, DIN, ss + (2 * L) * MH, rtab, u0.pm}; pg8::gemm_phase<pg8::EpiScaleBf16<0, false>, pg8::StaticOrder, true, true>(lds, g, S, E2); } else
#endif
              pg8::gemm_phase<pg8::EpiScaleBf16<0, true, true>, pg8::StaticOrder, true, true>(lds, g, S, E); }
            }
            GSYNC(); STAMP(PH_P1);
            for (int rep_ = 0; rep_ < REPS(PH_P2A); ++rep_) {
            for (int it = bx; it < HB * NH * NCH; it += G) { const int i = it & 31, h = (it >> 5) & 3, bl = it >> 7;
                const float log2g = __log2f(1.0f - ex2(-5.0f - (float)h));
                kv_item(lds, PROJ, ROT, KV + (size_t)it * 32768, bl * SEQ + i * CH, h, log2g, tid); }
            }
            GSYNC(); STAMP(PH_P2A);
            for (int rep_ = 0; rep_ < REPS(PH_P2B); ++rep_) {
            int tsc = tid; asm volatile("" : "+v"(tsc));
            for (int gidx = bx * NT + tsc; gidx < 16 * 8192; gidx += G * NT) { const int pair = gidx >> 13, e = (gidx & 8191) * 4, h = pair & 3;
                const float gC = ex2(128.0f * __log2f(1.0f - ex2(-5.0f - (float)h)));
                f32x4 s = (f32x4){0.f, 0.f, 0.f, 0.f};
                const size_t idx0 = (size_t)(pair * 32) * 32768 + e;
                { constexpr int i0 = 0; u32x2 kw[NCH];
#pragma unroll
                    for (int j = 0; j < NCH; ++j) kw[j] = *(const u32x2*)(KV + idx0 + (size_t)(i0 + j) * 32768);
#pragma unroll
                    for (int j = 0; j < NCH; ++j) { u32x2 o; o.x = pk2(s[0], s[1]); o.y = pk2(s[2], s[3]); *(u32x2*)(ST + idx0 + (size_t)(i0 + j) * 32768) = o;
                        const f32x4 kv = (f32x4){bflo(kw[j].x), bfhi(kw[j].x), bflo(kw[j].y), bfhi(kw[j].y)}; s = s * gC + kv; } } }
            }
            GSYNC(); STAMP(PH_P2B);
            for (int rep_ = 0; rep_ < REPS(PH_P2C); ++rep_) {
            if (bx & 8) for (int ci = bx; ci < MH / 64; ci += G) conv_item(PROJ, AB, conv_w + (size_t)L * 3 * D, ci, tid);
            for (int it = bx; it < HB * NH * NCH; it += G) { const int i = it & 31, h = (it >> 5) & 3, bl = it >> 7;
                const float log2g = __log2f(1.0f - ex2(-5.0f - (float)h));
                ret_item(lds, PROJ, ROT, ST + (size_t)it * 32768, AB, bl * SEQ + i * CH, h, log2g, tid); }
            if (!(bx & 8)) for (int ci = bx; ci < MH / 64; ci += G) conv_item(PROJ, AB, conv_w + (size_t)L * 3 * D, ci, tid);
            }
            GSYNC(); STAMP(PH_P2C);
            for (int rep_ = 0; rep_ < REPS(PH_P3); ++rep_) {
            { pg8::Gemm g{AB, (const bf16*)(wl + W_CR), MH, D, 2048}; pg8::StaticOrder S; S.init(MH, D, G, (int)__builtin_amdgcn_readfirstlane((int)stw[5]));
              pg8::EpiMerge E{PROJ, MG};
              pg8::gemm_phase<pg8::EpiMerge, pg8::StaticOrder, true, true>(lds, g, S, E); }
            }
            GSYNC(); STAMP(PH_P3);
            { pg8::Gemm g{MG, (const bf16*)(wl + W_O), MH, D, D}; pg8::StaticOrder S; S.init(MH, D, G, (int)__builtin_amdgcn_readfirstlane((int)stw[5]));
              pg8::EpiResidual E{L == 0 ? xh : (const float*)outh, outh, XB, ss + (2 * L + 1) * MH};
              pg8::gemm_phase<pg8::EpiResidual, pg8::StaticOrder, true, true>(lds, g, S, E); }
            GSYNC(); STAMP(PH_P4);
            for (int rep_ = 0; rep_ < REPS(PH_P5); ++rep_) {
            { pg8::Gemm g{XB, (const bf16*)(wl + W_UP), MH, FF, D}; pg8::StaticOrder S; S.init(MH, FF, G, (int)__builtin_amdgcn_readfirstlane((int)stw[5]));
              pg8::Unit u0{0, 0}; (void)S.next(0, u0);
              LAS float* rtab = (LAS float*)(lds + 131072); { int tr_ = tid; asm volatile("" : "+v"(tr_)); if (tr_ < 256) rtab[tr_] = rsqrtf((ss + (2 * L + 1) * MH)[u0.pm * 256 + tr_] * (1.0f / 1024.0f) + pg8::NORM_EPS); } __syncthreads();
              pg8::EpiScaleBf16<1> E{U, FF, ss + (2 * L + 1) * MH, rtab, u0.pm};
              pg8::gemm_phase<pg8::EpiScaleBf16<1>, pg8::StaticOrder, true, true>(lds, g, S, E); }
            }
            GSYNC(); STAMP(PH_P5);
            { pg8::Gemm g{U, (const bf16*)(wl + W_DN), MH, D, FF}; pg8::StaticOrder S; S.init(MH, D, G, (int)__builtin_amdgcn_readfirstlane((int)stw[5]));
              pg8::EpiResidual E{outh, outh, L + 1 < DEPTH ? XB : (bf16*)nullptr, ss + (2 * L + 2) * MH};
              pg8::gemm_phase<pg8::EpiResidual, pg8::StaticOrder, true, true>(lds, g, S, E); }
            GSYNC(); STAMP(PH_P6);
        }
        int lnf = lane; asm volatile("" : "+v"(lnf));
        { const f32x4* gr = (const f32x4*)norm_final + lnf; f32x4 gv[4];
#pragma unroll
          for (int j = 0; j < 4; ++j) gv[j] = gr[64 * j];
          for (int row0 = gw; row0 < MH; row0 += 4 * NGW) {
            f32x4 v[4][4]; float rs[4];
#pragma unroll
            for (int k = 0; k < 4; ++k) { const int row = min(row0 + k * NGW, MH - 1); const f32x4* xr = (const f32x4*)(outh + (size_t)row * D) + lnf; rs[k] = ss[4 * MH + row];
#pragma unroll
                for (int j = 0; j < 4; ++j) v[k][j] = xr[64 * j]; }
#pragma unroll
            for (int k = 0; k < 4; ++k) { const int row = row0 + k * NGW; if (row < MH) { f32x4* xr = (f32x4*)(outh + (size_t)row * D) + lnf;
                const float r = rsqrtf(rs[k] * (1.0f / 1024.0f) + pg8::NORM_EPS);
#pragma unroll
                for (int j = 0; j < 4; ++j) { f32x4 o = v[k][j] * r * gv[j];
#ifdef PROBE_A
                    if (hf == 1 && (row & 15) == 0) o = o + (float)tb_ * 0.01f;
#endif
                    xr[64 * j] = o; } } }
          } }
#ifdef PROBE_A
        if (hf == 1) { __syncthreads(); if (bx == 0 && tid == 0) args.out[0] = (float)ta_; }
#endif
    }
}

extern "C" void kernel_launch(void* const* d_in, const int* in_sizes, int n_in, void* d_out, int out_size, void* d_ws, size_t ws_size, hipStream_t stream) {
    static int grid = 0;
    if (grid == 0) {
        if (n_in != 13 || out_size != NB * SEQ * D || ws_size < WS_END) { fprintf(stderr, "kernel_launch: unexpected shapes (n_in %d, out %d, ws %zu < %zu)\n", n_in, out_size, ws_size, (size_t)WS_END); grid = -1; return; }
        int dev = 0, cus = 0, per_cu = 0;
        (void)hipGetDevice(&dev); (void)hipDeviceGetAttribute(&cus, hipDeviceAttributeMultiprocessorCount, dev);
        if (hipFuncSetAttribute((const void*)hybrid_fwd, hipFuncAttributeMaxDynamicSharedMemorySize, LDS_BYTES) != hipSuccess) { fprintf(stderr, "kernel_launch: hipFuncSetAttribute failed\n"); grid = -1; return; }
        if (hipOccupancyMaxActiveBlocksPerMultiprocessor(&per_cu, (const void*)hybrid_fwd, NT, LDS_BYTES) != hipSuccess || per_cu < 1) { fprintf(stderr, "kernel_launch: occupancy query says %d\n", per_cu); per_cu = 1; }
        (void)hipGetLastError();
        grid = cus * per_cu;
    }
    if (grid < 0) return;
    if (hipMemsetAsync((char*)d_ws + WS_BAR, 0, BAR_BYTES, stream) != hipSuccess) { fprintf(stderr, "kernel_launch: memset failed\n"); return; }
    Args a{};
    for (int i = 0; i < 13; ++i) a.in[i] = (const float*)d_in[i];
    a.out = (float*)d_out; a.ws = (unsigned char*)d_ws;
    void* kargs[] = {&a};
    hipError_t e = hipLaunchCooperativeKernel((const void*)hybrid_fwd, dim3(grid), dim3(NT), kargs, LDS_BYTES, stream);
    if (e != hipSuccess) fprintf(stderr, "kernel_launch: cooperative launch failed: %s (grid %d)\n", hipGetErrorString(e), grid);
}
```
